# Optimizing an MI355X kernel written in HIP

```python
import math
import jax
import jax.numpy as jnp
from jax import lax
import numpy as np

D_MODEL = 1024
BATCH = 8
SEQ = 2048
DEPTH = 2
DEC_BATCH = 128
DEC_SEQ = 1
PAST_LEN = 16384
PAGE_SIZE = 128

N_META = 16
D_FF = ((8 * D_MODEL // 3 + 255) // 256) * 256
NORM_EPS = 1e-6
FFN_RES_SCALE = 0.5
S5_WIDTH = 3 * D_MODEL // 8
S5_GROUP = 16
S5_GROUPS = S5_WIDTH // S5_GROUP
S5_STATE = 64
RWKV_HEAD = 64
RWKV_WIDTH = 3 * D_MODEL // 8
RWKV_HEADS = RWKV_WIDTH // RWKV_HEAD
DECAY_RANK = 64
ICL_RANK = 64
GATE_RANK = 128
RWKV_PROJ = 3 * RWKV_WIDTH + DECAY_RANK + ICL_RANK + GATE_RANK
RWKV_LN_EPS = 64e-5
LRU_WIDTH = D_MODEL // 4
LRU_BLOCKS = 4
LRU_BLOCK = LRU_WIDTH // LRU_BLOCKS
CONV_WIDTH = 4
LRU_C = 8.0
D_MIX = S5_WIDTH + RWKV_WIDTH + LRU_WIDTH
D_IN = S5_WIDTH + RWKV_PROJ + 2 * LRU_WIDTH

kernel_name = 'hybrid_s5_rwkv7_rglru_decode_step'


def rmsnorm(x, g):
    xf = x.astype(jnp.float32)
    y = xf * lax.rsqrt(jnp.mean(xf * xf, axis=-1, keepdims=True) + NORM_EPS)
    return (y * g.astype(jnp.float32)).astype(x.dtype)


def swiglu(x, w_gate, w_up, w_down):
    return (jax.nn.silu(x @ w_gate) * (x @ w_up)) @ w_down


def s5_group_mixer(u, h0_re, h0_im, lam_re, lam_im, log_dt, b_re, b_im, c_re, c_im, d_skip, glu_w, glu_b):
    f32 = jnp.float32
    bsz, L, _ = u.shape
    uf = u.astype(f32)
    ug = uf.reshape(bsz, L, S5_GROUPS, S5_GROUP)
    lr = lam_re.astype(f32)
    li = lam_im.astype(f32)
    dt = jnp.exp(log_dt.astype(f32))[:, None]
    mag = jnp.exp(lr * dt)
    ab_re = mag * jnp.cos(li * dt)
    ab_im = mag * jnp.sin(li * dt)
    den = lr * lr + li * li
    f_re = ((ab_re - 1.0) * lr + ab_im * li) / den
    f_im = (ab_im * lr - (ab_re - 1.0) * li) / den
    br = b_re.astype(f32)
    bi = b_im.astype(f32)
    bb_re = f_re[..., None] * br - f_im[..., None] * bi
    bb_im = f_re[..., None] * bi + f_im[..., None] * br
    x_re = jnp.einsum('gnc,blgc->blgn', bb_re, ug)
    x_im = jnp.einsum('gnc,blgc->blgn', bb_im, ug)
    h0r = h0_re.astype(f32)
    h0i = h0_im.astype(f32)
    x_re = x_re.at[:, 0].add(ab_re * h0r - ab_im * h0i)
    x_im = x_im.at[:, 0].add(ab_re * h0i + ab_im * h0r)
    a_re = jnp.broadcast_to(ab_re, (1, L) + ab_re.shape)
    a_im = jnp.broadcast_to(ab_im, (1, L) + ab_im.shape)

    def combine(e1, e2):
        a1r, a1i, b1r, b1i = e1
        a2r, a2i, b2r, b2i = e2
        return (a1r * a2r - a1i * a2i, a1r * a2i + a1i * a2r,
                a2r * b1r - a2i * b1i + b2r, a2r * b1i + a2i * b1r + b2i)

    _, _, h_re, h_im = lax.associative_scan(combine, (a_re, a_im, x_re, x_im), axis=1)
    y = (jnp.einsum('gcn,blgn->blgc', c_re.astype(f32), h_re)
         - jnp.einsum('gcn,blgn->blgc', c_im.astype(f32), h_im)).reshape(bsz, L, S5_WIDTH)
    y = y + d_skip.astype(f32) * uf
    z = jax.nn.gelu(y)
    out = z * jax.nn.sigmoid(z @ glu_w.astype(f32) + glu_b.astype(f32))
    return out, h_re[:, -1], h_im[:, -1]


def rwkv7_group_mixer(p, shift0, state0, mu, w0, w_up, a0, a_up, g_up, k_k, k_a, r_k, ln_w, ln_b):
    f32 = jnp.float32
    bsz, L, _ = p.shape
    pf = p.astype(f32)
    prev = jnp.concatenate([shift0.astype(f32)[:, None], pf[:, :-1]], axis=1)
    xm = pf + (prev - pf) * mu.astype(f32)
    W = RWKV_WIDTH
    r, k, v, xw, xa, xg = jnp.split(xm, [W, 2 * W, 3 * W, 3 * W + DECAY_RANK, 3 * W + DECAY_RANK + ICL_RANK], axis=-1)
    logw = -jax.nn.softplus(-(w0.astype(f32) + jnp.tanh(xw) @ w_up.astype(f32))) - 0.5
    decay = jnp.exp(-jnp.exp(logw))
    a = jax.nn.sigmoid(a0.astype(f32) + xa @ a_up.astype(f32))
    g = jax.nn.sigmoid(xg) @ g_up.astype(f32)
    hs = (bsz, L, RWKV_HEADS, RWKV_HEAD)
    kk = (k * k_k.astype(f32)).reshape(hs)
    kk = kk / jnp.maximum(jnp.sqrt(jnp.sum(kk * kk, axis=-1, keepdims=True)), 1e-12)
    k = k * (1.0 + (a - 1.0) * k_a.astype(f32))
    rh, kh, vh, wh, ah = (t.reshape(hs) for t in (r, k, v, decay, a))

    def step(S, inp):
        r_t, w_t, k_t, v_t, kk_t, a_t = inp
        sa = jnp.einsum('bhvk,bhk->bhv', S, -kk_t)
        S = (S * w_t[:, :, None, :] + sa[..., None] * (kk_t * a_t)[:, :, None, :]
             + v_t[..., None] * k_t[:, :, None, :])
        return S, jnp.einsum('bhvk,bhk->bhv', S, r_t)

    tm = lambda t: jnp.swapaxes(t, 0, 1)
    S_fin, ys = lax.scan(step, state0.astype(f32), (tm(rh), tm(wh), tm(kh), tm(vh), tm(kk), tm(ah)))
    y = tm(ys)
    mean = jnp.mean(y, axis=-1, keepdims=True)
    var = jnp.mean(jnp.square(y - mean), axis=-1, keepdims=True)
    yn = ((y - mean) * lax.rsqrt(var + RWKV_LN_EPS)).reshape(bsz, L, W) * ln_w.astype(f32) + ln_b.astype(f32)
    bonus = jnp.sum(rh * kh * r_k.astype(f32), axis=-1, keepdims=True) * vh
    out = (yn + bonus.reshape(bsz, L, W)) * g
    return out, S_fin, p[:, -1]


def rglru_group_mixer(xb, gb, conv0, h0, conv_w, conv_b, w_a, b_a, w_x, b_x, lam):
    f32 = jnp.float32
    bsz, L, _ = xb.shape
    xp = jnp.concatenate([conv0.astype(f32), xb.astype(f32)], axis=1)
    xc = conv_b.astype(f32) + xp[:, 0:L] * conv_w[0].astype(f32)
    for j in range(1, CONV_WIDTH):
        xc = xc + xp[:, j:j + L] * conv_w[j].astype(f32)
    xh = xc.reshape(bsz, L, LRU_BLOCKS, LRU_BLOCK)
    gate_a = jax.nn.sigmoid(jnp.einsum('blhi,hij->blhj', xh, w_a.astype(f32)).reshape(bsz, L, LRU_WIDTH) + b_a.astype(f32))
    gate_x = jax.nn.sigmoid(jnp.einsum('blhi,hij->blhj', xh, w_x.astype(f32)).reshape(bsz, L, LRU_WIDTH) + b_x.astype(f32))
    log_a = LRU_C * gate_a * jax.nn.log_sigmoid(lam.astype(f32))
    a = jnp.exp(log_a)
    b = jnp.sqrt(-jnp.expm1(2.0 * log_a)) * (gate_x * xc)
    b = b.at[:, 0].add(a[:, 0] * h0.astype(f32))

    def combine(e1, e2):
        a1, b1 = e1
        a2, b2 = e2
        return (a1 * a2, a2 * b1 + b2)

    _, h = lax.associative_scan(combine, (a, b), axis=1)
    out = h * jax.nn.gelu(gb.astype(f32))
    return out, h[:, -1], xp[:, -(CONV_WIDTH - 1):]


def layer_forward(x, s5_re0, s5_im0, rwkv0, shift0, lru0, conv0,
                  ffn1_norm, ffn1_w_gate, ffn1_w_up, ffn1_w_down, mix_norm, w_in,
                  s5_lambda_re, s5_lambda_im, s5_log_dt, s5_b_re, s5_b_im, s5_c_re, s5_c_im, s5_d, s5_glu_w, s5_glu_b,
                  rwkv_mu, rwkv_w0, rwkv_w_up, rwkv_a0, rwkv_a_up, rwkv_g_up, rwkv_k_k, rwkv_k_a, rwkv_r_k, rwkv_ln_w, rwkv_ln_b,
                  lru_conv_w, lru_conv_b, lru_w_a, lru_b_a, lru_w_x, lru_b_x, lru_lambda,
                  w_out, ffn2_norm, ffn2_w_gate, ffn2_w_up, ffn2_w_down):
    h = x + FFN_RES_SCALE * swiglu(rmsnorm(x, ffn1_norm), ffn1_w_gate, ffn1_w_up, ffn1_w_down)
    proj = rmsnorm(h, mix_norm) @ w_in
    u_s5, p_rwkv, x_lru, g_lru = jnp.split(
        proj, [S5_WIDTH, S5_WIDTH + RWKV_PROJ, S5_WIDTH + RWKV_PROJ + LRU_WIDTH], axis=-1)
    o_s5, s5_re, s5_im = s5_group_mixer(u_s5, s5_re0, s5_im0, s5_lambda_re, s5_lambda_im, s5_log_dt,
                                        s5_b_re, s5_b_im, s5_c_re, s5_c_im, s5_d, s5_glu_w, s5_glu_b)
    o_rwkv, rwkv_s, shift = rwkv7_group_mixer(p_rwkv, shift0, rwkv0, rwkv_mu, rwkv_w0, rwkv_w_up, rwkv_a0,
                                              rwkv_a_up, rwkv_g_up, rwkv_k_k, rwkv_k_a, rwkv_r_k, rwkv_ln_w, rwkv_ln_b)
    o_lru, lru_h, conv = rglru_group_mixer(x_lru, g_lru, conv0, lru0, lru_conv_w, lru_conv_b,
                                           lru_w_a, lru_b_a, lru_w_x, lru_b_x, lru_lambda)
    mix = jnp.concatenate([o_s5, o_rwkv, o_lru], axis=-1).astype(x.dtype) @ w_out
    h = h + mix
    h = h + FFN_RES_SCALE * swiglu(rmsnorm(h, ffn2_norm), ffn2_w_gate, ffn2_w_up, ffn2_w_down)
    return h, s5_re, s5_im, rwkv_s, shift, lru_h, conv


def setup_inputs(seed: int = 0) -> dict:
    key = jax.random.key(seed)
    ks = iter(jax.random.split(key, 64))
    f32 = jnp.float32

    def nrm(shape, scale):
        return scale * jax.random.normal(next(ks), shape, f32)

    def unif(shape, lo, hi):
        return jax.random.uniform(next(ks), shape, f32, lo, hi)

    L = DEPTH
    lam_im0 = jnp.pi * jnp.arange(S5_STATE, dtype=f32)
    s_lru = unif((L, LRU_WIDTH), 0.9, 0.999) ** (1.0 / LRU_C)
    return {
        'x_prompt': nrm((BATCH, SEQ, D_MODEL), 1.0),
        'x_sample': nrm((DEC_BATCH, DEC_SEQ, D_MODEL), 1.0),
        'state_s5_re': nrm((L, DEC_BATCH, S5_GROUPS, S5_STATE), 0.5),
        'state_s5_im': nrm((L, DEC_BATCH, S5_GROUPS, S5_STATE), 0.5),
        'state_rwkv': nrm((L, DEC_BATCH, RWKV_HEADS, RWKV_HEAD, RWKV_HEAD), 0.2),
        'state_rwkv_shift': nrm((L, DEC_BATCH, RWKV_PROJ), 1.0),
        'state_lru': nrm((L, DEC_BATCH, LRU_WIDTH), 0.5),
        'state_lru_conv': nrm((L, DEC_BATCH, CONV_WIDTH - 1, LRU_WIDTH), 1.0),
        'meta_tokens': nrm((N_META, D_MODEL), 1.0),
        'ffn1_norm': 1.0 + nrm((L, D_MODEL), 0.02),
        'ffn1_w_gate': nrm((L, D_MODEL, D_FF), D_MODEL ** -0.5),
        'ffn1_w_up': nrm((L, D_MODEL, D_FF), D_MODEL ** -0.5),
        'ffn1_w_down': nrm((L, D_FF, D_MODEL), D_FF ** -0.5),
        'mix_norm': 1.0 + nrm((L, D_MODEL), 0.02),
        'w_in': nrm((L, D_MODEL, D_IN), D_MODEL ** -0.5),
        's5_lambda_re': -0.5 + nrm((L, S5_GROUPS, S5_STATE), 0.01),
        's5_lambda_im': lam_im0 + nrm((L, S5_GROUPS, S5_STATE), 0.01),
        's5_log_dt': unif((L, S5_GROUPS), math.log(1e-3), math.log(1e-1)),
        's5_b_re': nrm((L, S5_GROUPS, S5_STATE, S5_GROUP), (2 * S5_GROUP) ** -0.5),
        's5_b_im': nrm((L, S5_GROUPS, S5_STATE, S5_GROUP), (2 * S5_GROUP) ** -0.5),
        's5_c_re': nrm((L, S5_GROUPS, S5_GROUP, S5_STATE), (2 * S5_STATE) ** -0.5),
        's5_c_im': nrm((L, S5_GROUPS, S5_GROUP, S5_STATE), (2 * S5_STATE) ** -0.5),
        's5_d': nrm((L, S5_WIDTH), 0.5),
        's5_glu_w': nrm((L, S5_WIDTH, S5_WIDTH), S5_WIDTH ** -0.5),
        's5_glu_b': nrm((L, S5_WIDTH), 0.01),
        'rwkv_mu': unif((L, RWKV_PROJ), 0.0, 1.0),
        'rwkv_w0': unif((L, RWKV_WIDTH), -6.0, -1.0),
        'rwkv_w_up': nrm((L, DECAY_RANK, RWKV_WIDTH), 0.1),
        'rwkv_a0': nrm((L, RWKV_WIDTH), 0.1),
        'rwkv_a_up': nrm((L, ICL_RANK, RWKV_WIDTH), ICL_RANK ** -0.5),
        'rwkv_g_up': nrm((L, GATE_RANK, RWKV_WIDTH), GATE_RANK ** -0.5),
        'rwkv_k_k': 0.85 + nrm((L, RWKV_WIDTH), 0.02),
        'rwkv_k_a': 1.0 + nrm((L, RWKV_WIDTH), 0.02),
        'rwkv_r_k': nrm((L, RWKV_HEADS, RWKV_HEAD), 0.1),
        'rwkv_ln_w': 1.0 + nrm((L, RWKV_WIDTH), 0.02),
        'rwkv_ln_b': nrm((L, RWKV_WIDTH), 0.01),
        'lru_conv_w': nrm((L, CONV_WIDTH, LRU_WIDTH), CONV_WIDTH ** -0.5),
        'lru_conv_b': nrm((L, LRU_WIDTH), 0.01),
        'lru_w_a': nrm((L, LRU_BLOCKS, LRU_BLOCK, LRU_BLOCK), LRU_BLOCK ** -0.5),
        'lru_b_a': nrm((L, LRU_WIDTH), 0.01),
        'lru_w_x': nrm((L, LRU_BLOCKS, LRU_BLOCK, LRU_BLOCK), LRU_BLOCK ** -0.5),
        'lru_b_x': nrm((L, LRU_WIDTH), 0.01),
        'lru_lambda': jnp.log(s_lru) - jnp.log1p(-s_lru),
        'w_out': nrm((L, D_MIX, D_MODEL), D_MIX ** -0.5),
        'ffn2_norm': 1.0 + nrm((L, D_MODEL), 0.02),
        'ffn2_w_gate': nrm((L, D_MODEL, D_FF), D_MODEL ** -0.5),
        'ffn2_w_up': nrm((L, D_MODEL, D_FF), D_MODEL ** -0.5),
        'ffn2_w_down': nrm((L, D_FF, D_MODEL), D_FF ** -0.5),
        'final_norm': 1.0 + nrm((D_MODEL,), 0.02),
    }


def reference(x_prompt, x_sample, state_s5_re, state_s5_im, state_rwkv, state_rwkv_shift, state_lru, state_lru_conv,
              meta_tokens, ffn1_norm, ffn1_w_gate, ffn1_w_up, ffn1_w_down, mix_norm, w_in,
              s5_lambda_re, s5_lambda_im, s5_log_dt, s5_b_re, s5_b_im, s5_c_re, s5_c_im, s5_d, s5_glu_w, s5_glu_b,
              rwkv_mu, rwkv_w0, rwkv_w_up, rwkv_a0, rwkv_a_up, rwkv_g_up, rwkv_k_k, rwkv_k_a, rwkv_r_k, rwkv_ln_w, rwkv_ln_b,
              lru_conv_w, lru_conv_b, lru_w_a, lru_b_a, lru_w_x, lru_b_x, lru_lambda,
              w_out, ffn2_norm, ffn2_w_gate, ffn2_w_up, ffn2_w_down, final_norm):
    f32 = jnp.float32
    bp = x_prompt.shape[0]
    meta = jnp.broadcast_to(meta_tokens.astype(x_prompt.dtype)[None], (bp, N_META, D_MODEL))
    xp = jnp.concatenate([meta, x_prompt], axis=1)
    xs = x_sample
    p_list = []
    s_list = []
    for l in range(DEPTH):
        lp = (ffn1_norm[l], ffn1_w_gate[l], ffn1_w_up[l], ffn1_w_down[l], mix_norm[l], w_in[l],
              s5_lambda_re[l], s5_lambda_im[l], s5_log_dt[l], s5_b_re[l], s5_b_im[l], s5_c_re[l], s5_c_im[l],
              s5_d[l], s5_glu_w[l], s5_glu_b[l],
              rwkv_mu[l], rwkv_w0[l], rwkv_w_up[l], rwkv_a0[l], rwkv_a_up[l], rwkv_g_up[l], rwkv_k_k[l],
              rwkv_k_a[l], rwkv_r_k[l], rwkv_ln_w[l], rwkv_ln_b[l],
              lru_conv_w[l], lru_conv_b[l], lru_w_a[l], lru_b_a[l], lru_w_x[l], lru_b_x[l], lru_lambda[l],
              w_out[l], ffn2_norm[l], ffn2_w_gate[l], ffn2_w_up[l], ffn2_w_down[l])
        xp, *new_p = layer_forward(
            xp,
            jnp.zeros((bp, S5_GROUPS, S5_STATE), f32), jnp.zeros((bp, S5_GROUPS, S5_STATE), f32),
            jnp.zeros((bp, RWKV_HEADS, RWKV_HEAD, RWKV_HEAD), f32), jnp.zeros((bp, RWKV_PROJ), f32),
            jnp.zeros((bp, LRU_WIDTH), f32), jnp.zeros((bp, CONV_WIDTH - 1, LRU_WIDTH), f32),
            *lp)
        xs, *new_s = layer_forward(
            xs, state_s5_re[l], state_s5_im[l], state_rwkv[l], state_rwkv_shift[l],
            state_lru[l], state_lru_conv[l], *lp)
        p_list.append(new_p)
        s_list.append(new_s)
    p_new = [jnp.stack([st[i] for st in p_list], axis=0) for i in range(6)]
    s_new = [jnp.stack([st[i] for st in s_list], axis=0) for i in range(6)]
    y_prompt = rmsnorm(xp, final_norm)[:, N_META:]
    y_sample = rmsnorm(xs, final_norm)
    return (y_prompt, y_sample,
            p_new[0], p_new[1], p_new[2], p_new[3], p_new[4], p_new[5],
            s_new[0], s_new[1], s_new[2], s_new[3], s_new[4], s_new[5])
```

```cpp
#include <hip/hip_runtime.h>
#include <hip/hip_cooperative_groups.h>
#include <cstdio>
namespace cg = cooperative_groups;
namespace pg8 {
#define PG8_LAS __attribute__((address_space(3)))
typedef unsigned short bf16_t;
typedef short bf16x8 __attribute__((ext_vector_type(8)));
typedef float f32x4 __attribute__((ext_vector_type(4)));
typedef unsigned u32x4 __attribute__((ext_vector_type(4)));
constexpr int BM = 256, BK = 64, HALF = 128, HTB = HALF * BK * 2  , STAGE_BYTES = 8 * HTB, NXCD = 8, WGM = 8;

__host__ __device__ __forceinline__ int lds_byte(int r, int c) { const int st = (r >> 4) * 2 + (c >> 5), rr = r & 15, cc = c & 31, ob = rr * 64 + cc * 2; return st * 1024 + (ob ^ (((ob >> 9) & 1) << 5)); }
__host__ __device__ __forceinline__ void stage_rc(int b, int& R, int& C) { const int st = b / 1024, sb = b % 1024, swz = sb ^ (((sb >> 9) & 1) << 5); R = (st >> 1) * 16 + swz / 64; C = (st & 1) * 32 + (swz % 64) / 2; }
__host__ __device__ __forceinline__ int perm32(int rho) { const int n = rho >> 4, i = rho & 15; return 8 * (i >> 2) + 4 * n + (i & 3); }

struct Unit { int pm, pn; };
struct Gemm { const bf16_t* A; const bf16_t* Bt; int M, N, K; };

struct StaticOrder {
    int nM, nN, nwg, G, c;
    __host__ __device__ void init(int M, int N, int G_, int c_) { nM = M / BM; nN = N / BM; nwg = nM * nN; G = G_; c = c_; }
    __host__ __device__ bool next(int i, Unit& u) const {
        const long L = (long)i * G + c; if (L >= nwg) return false;
        int wgid = (int)L; { const int q = nwg / NXCD, r = nwg % NXCD, xcd = wgid % NXCD, off = wgid / NXCD; wgid = (xcd < r ? xcd * (q + 1) : r * (q + 1) + (xcd - r) * q) + off; }
        const int nig = WGM * nN, gid = wgid / nig, fm = gid * WGM, gsz = (nM - fm) < WGM ? (nM - fm) : WGM;
        u.pm = fm + ((wgid % nig) % gsz); u.pn = (wgid % nig) / gsz; return true;
    }
    __device__ __forceinline__ void a_ready(const Unit&) const {}
    __device__ __forceinline__ void done(const Unit&) const {}
};
__device__ __forceinline__ unsigned cvt_pk_bf16(float lo, float hi) { unsigned r; asm volatile("v_cvt_pk_bf16_f32 %0, %1, %2" : "=v"(r) : "v"(lo), "v"(hi)); return r; }
template <class Epi, class Sched, bool STAMP = false>
__device__ __forceinline__ void gemm_phase(PG8_LAS unsigned char* lds, const Gemm g, const Sched& S, const Epi& E, unsigned long long* stamps) {
    int tid_ = threadIdx.x; asm volatile("" : "+v"(tid_));
    const int tid = tid_, wid = __builtin_amdgcn_readfirstlane(tid >> 6), lane = tid & 63, wr = wid >> 2, wc = wid & 3, fr = lane & 15, fq = lane >> 4;
    const int K = g.K, nt = K / BK;
    int ts_lo = 0, ts_hi = 0, nts = 0; const unsigned long long rt_entry = STAMP ? (unsigned long long)wall_clock64() : 0ull;
#define PG8_STAMP() do { if (STAMP && wid == 0 && nts < 64) { const unsigned long long _c = (unsigned long long)clock64(); \
        ts_lo = (lane == nts) ? (int)(unsigned)_c : ts_lo; ts_hi = (lane == nts) ? (int)(unsigned)(_c >> 32) : ts_hi; ++nts; } } while (0)
    PG8_STAMP();
    unsigned voffA[2], voffB[2];
#pragma unroll
    for (int i = 0; i < 2; ++i) { int R, C; stage_rc(tid * 16 + i * 8192, R, C); const int Rb = Epi::PERM ? ((R & ~31) + perm32(R & 31)) : R;
        voffA[i] = (unsigned)(R * K + C) * 2u; voffB[i] = (unsigned)(Rb * K + C) * 2u; }
    const size_t kstep = (size_t)(BK * 2);
    const size_t hstep = (size_t)HALF * K * 2;
    const size_t tstep = 2 * hstep;
    const unsigned ldsw = (unsigned)wid * 1024u;
    const int aoff = lds_byte(wr * 64 + fr, fq * 8), boff = lds_byte(wc * 32 + fr, fq * 8);
#define PG8_SA(b, h) (((b) * 2 + (h)) * HTB)
#define PG8_SB(b, h) ((4 + (b) * 2 + (h)) * HTB)
#define PG8_STAGE(bufoff, gbase, voff) do { _Pragma("unroll") for (int _i = 0; _i < 2; ++_i) \
        __builtin_amdgcn_global_load_lds((const unsigned*)((const char*)(gbase) + (voff)[_i]), (PG8_LAS unsigned*)(lds + (bufoff) + ldsw + _i * 8192), 16, 0, 0); } while (0)
#define PG8_LDA(dst, b, h) do { _Pragma("unroll") for (int m = 0; m < 4; ++m) _Pragma("unroll") for (int k = 0; k < 2; ++k) dst[m][k] = *(const PG8_LAS bf16x8*)(lds + PG8_SA(b, h) + aoff + m * 2048 + k * 1024); } while (0)
#define PG8_LDB(dst, b, h) do { _Pragma("unroll") for (int n = 0; n < 2; ++n) _Pragma("unroll") for (int k = 0; k < 2; ++k) dst[n][k] = *(const PG8_LAS bf16x8*)(lds + PG8_SB(b, h) + boff + n * 2048 + k * 1024); } while (0)
#define PG8_MMA(ai, bj, At, Bt) do { __builtin_amdgcn_s_setprio(1); _Pragma("unroll") for (int m = 0; m < 4; ++m) _Pragma("unroll") for (int n = 0; n < 2; ++n) _Pragma("unroll") for (int k = 0; k < 2; ++k) \
        acc[ai][bj][m][n] = __builtin_amdgcn_mfma_f32_16x16x32_bf16(Bt[n][k], At[m][k], acc[ai][bj][m][n], 0, 0, 0); __builtin_amdgcn_s_setprio(0); } while (0)
#define PG8_WAIT_V(n) asm volatile("s_waitcnt vmcnt(" #n ")" ::: "memory")
#define PG8_WAIT_L(n) asm volatile("s_waitcnt lgkmcnt(" #n ")" ::: "memory")
#define PG8_BAR __builtin_amdgcn_s_barrier()
#define PG8_SCHED __builtin_amdgcn_sched_barrier(0)
    Unit cur, nxt; int ui = 0;
    if (!S.next(0, cur)) return;
    f32x4 acc[2][2][4][2];
#pragma unroll
    for (int a = 0; a < 2; ++a)
#pragma unroll
        for (int b = 0; b < 2; ++b)
#pragma unroll
            for (int m = 0; m < 4; ++m)
#pragma unroll
                for (int n = 0; n < 2; ++n) acc[a][b][m][n] = (f32x4){0.f, 0.f, 0.f, 0.f};
    bf16x8 At[4][2], B0[2][2], B1[2][2];
    const char* cA = (const char*)g.A + (size_t)cur.pm * tstep; const char* cB = (const char*)g.Bt + (size_t)cur.pn * tstep;
    S.a_ready(cur);
    PG8_STAGE(PG8_SB(0, 0), cB, voffB); PG8_STAGE(PG8_SA(0, 0), cA, voffA); PG8_STAGE(PG8_SB(0, 1), cB + hstep, voffB); PG8_STAGE(PG8_SA(0, 1), cA + hstep, voffA);
    if (wr == 1) PG8_BAR;
    PG8_WAIT_V(4); PG8_BAR;
    PG8_STAGE(PG8_SB(1, 0), cB + kstep, voffB); PG8_STAGE(PG8_SA(1, 0), cA + kstep, voffA); PG8_STAGE(PG8_SB(1, 1), cB + hstep + kstep, voffB);
    PG8_WAIT_V(6); PG8_BAR;
    PG8_STAMP();
    for (;;) {
        const bool has_next = S.next(ui + 1, nxt);
        const char* nA = has_next ? (const char*)g.A + (size_t)nxt.pm * tstep : cA; const char* nB = has_next ? (const char*)g.Bt + (size_t)nxt.pn * tstep : cB;
        for (int t = 0; t < nt; t += 2) {
            const bool last = (t == nt - 2);
            const char* a1 = cA + (size_t)(t + 1) * kstep;
            const char* a2 = last ? nA : cA + (size_t)(t + 2) * kstep; const char* b2 = last ? nB : cB + (size_t)(t + 2) * kstep;
            const char* a3 = a2 + kstep; const char* b3 = b2 + kstep;
            if (last && has_next) S.a_ready(nxt);
            PG8_LDB(B0, 0, 0); PG8_SCHED; PG8_LDA(At, 0, 0); PG8_STAGE(PG8_SA(1, 1), a1 + hstep, voffA);
            PG8_WAIT_L(8); PG8_BAR; PG8_WAIT_L(0); PG8_MMA(0, 0, At, B0); PG8_BAR; PG8_SCHED;
            PG8_LDB(B1, 0, 1); PG8_STAGE(PG8_SB(0, 0), b2, voffB);
            PG8_BAR; PG8_WAIT_L(0); PG8_MMA(0, 1, At, B1); PG8_BAR;
            PG8_LDA(At, 0, 1); PG8_STAGE(PG8_SA(0, 0), a2, voffA);
            PG8_BAR; PG8_WAIT_L(0); PG8_MMA(1, 0, At, B0); PG8_BAR; PG8_SCHED;
            PG8_STAGE(PG8_SB(0, 1), b2 + hstep, voffB);
            PG8_WAIT_V(6); PG8_BAR; PG8_MMA(1, 1, At, B1); PG8_BAR;
            PG8_LDB(B0, 1, 0); PG8_SCHED; PG8_LDA(At, 1, 0); PG8_STAGE(PG8_SA(0, 1), a2 + hstep, voffA);
            PG8_WAIT_L(8); PG8_BAR; PG8_WAIT_L(0); PG8_MMA(0, 0, At, B0); PG8_BAR; PG8_SCHED;
            PG8_LDB(B1, 1, 1); PG8_STAGE(PG8_SB(1, 0), b3, voffB);
            PG8_BAR; PG8_WAIT_L(0); PG8_MMA(0, 1, At, B1); PG8_BAR;
            PG8_LDA(At, 1, 1); PG8_STAGE(PG8_SA(1, 0), a3, voffA);
            PG8_BAR; PG8_WAIT_L(0); PG8_MMA(1, 0, At, B0); PG8_BAR; PG8_SCHED;
            PG8_STAGE(PG8_SB(1, 1), b3 + hstep, voffB);
            PG8_WAIT_V(6); PG8_BAR; PG8_MMA(1, 1, At, B1); PG8_BAR;
        }
        PG8_STAMP();
        if constexpr (!Epi::AFTER_DRAIN) { E(acc, cur, wr, wc, fr, fq); S.done(cur); }
        PG8_STAMP();
        if (!has_next) break;
#pragma unroll
        for (int a = 0; a < 2; ++a)
#pragma unroll
            for (int b = 0; b < 2; ++b)
#pragma unroll
                for (int m = 0; m < 4; ++m)
#pragma unroll
                    for (int n = 0; n < 2; ++n) acc[a][b][m][n] = (f32x4){0.f, 0.f, 0.f, 0.f};
        cur = nxt; cA = nA; cB = nB; ++ui;
    }
    PG8_WAIT_V(0);
    if (wr == 0) PG8_BAR;
    PG8_BAR;
    if constexpr (Epi::AFTER_DRAIN) { E.fused(acc, cur, wr, wc, fr, fq, lds, wid, lane); S.done(cur); }
    PG8_STAMP();
    if (STAMP && wid == 0) { stamps[lane] = lane < nts ? (((unsigned long long)(unsigned)ts_hi << 32) | (unsigned)ts_lo) : 0ull;
        if (lane == 62) stamps[62] = rt_entry; if (lane == 63) stamps[63] = (unsigned long long)wall_clock64(); }
#undef PG8_STAMP
#undef PG8_SA
#undef PG8_SB
#undef PG8_STAGE
#undef PG8_LDA
#undef PG8_LDB
#undef PG8_MMA
#undef PG8_WAIT_V
#undef PG8_WAIT_L
#undef PG8_BAR
#undef PG8_SCHED
}
}
using pg8::bf16_t; using pg8::f32x4; using pg8::Unit; using pg8::Gemm; using pg8::StaticOrder; using pg8::cvt_pk_bf16;
#define DEVI __device__ __forceinline__
typedef _Float16 half_t;
typedef _Float16 h4 __attribute__((ext_vector_type(4)));

constexpr int DM = 1024, DFF = 2816, NB = 8, NMETA = 16, SEQ = 2048, LP = SEQ + NMETA, MP = NB * LP, NS = 128, M = MP + NS;
constexpr int DIN = 2304, S5G = 24, RH = 6, RPROJ = 1408;
constexpr int NC = 43, LC = 48;
static_assert(NC * LC == LP, "chunking");
static_assert(M % 256 == 0, "rows");
enum { I_XP = 0, I_XS, I_S5RE, I_S5IM, I_RWKV, I_SHIFT, I_LRU, I_CONV, I_META, I_F1N, I_F1G, I_F1U, I_F1D, I_MIXN, I_WIN,
       I_LAMRE, I_LAMIM, I_LOGDT, I_BRE, I_BIM, I_CRE, I_CIM, I_S5D, I_GLUW, I_GLUB,
       I_MU, I_W0, I_WUP, I_A0, I_AUP, I_GUP, I_KK, I_KA, I_RK, I_LNW, I_LNB,
       I_CW, I_CB, I_WA, I_BA, I_WX, I_BX, I_LAM, I_WOUT, I_F2N, I_F2G, I_F2U, I_F2D, I_FINN, N_IN };
constexpr size_t O_YP = 0, O_YS = O_YP + (size_t)NB * SEQ * DM, O_PS5RE = O_YS + (size_t)NS * DM, O_PS5IM = O_PS5RE + 2 * NB * 24 * 64,
    O_PRWKV = O_PS5IM + 2 * NB * 24 * 64, O_PSHIFT = O_PRWKV + (size_t)2 * NB * 6 * 4096, O_PLRU = O_PSHIFT + 2 * NB * 1408, O_PCONV = O_PLRU + 2 * NB * 256,
    O_SS5RE = O_PCONV + 2 * NB * 3 * 256, O_SS5IM = O_SS5RE + (size_t)2 * NS * 24 * 64, O_SRWKV = O_SS5IM + (size_t)2 * NS * 24 * 64,
    O_SSHIFT = O_SRWKV + (size_t)2 * NS * 6 * 4096, O_SLRU = O_SSHIFT + (size_t)2 * NS * 1408, O_SCONV = O_SLRU + (size_t)2 * NS * 256, O_END = O_SCONV + (size_t)2 * NS * 3 * 256;
static_assert(O_END == 25090048, "out size");
constexpr size_t SZ_WGU = 5632ull * 1024 * 2, SZ_WD = 1024ull * 2816 * 2, SZ_WIN = 2304ull * 1024 * 2, SZ_WOUT = 1024ull * 1024 * 2, SZ_WLR = 1280ull * 256 * 2,
    SZ_WLRU = 512ull * 256 * 2, SZ_WGLU = 512ull * 384 * 2;
constexpr size_t OFF_WGU = 0, OFF_WD = OFF_WGU + SZ_WGU, OFF_WIN = OFF_WD + SZ_WD, OFF_WOUT = OFF_WIN + SZ_WIN, OFF_WLR = OFF_WOUT + SZ_WOUT, OFF_WLRU = OFF_WLR + SZ_WLR,
    OFF_WGLU = OFF_WLRU + SZ_WLRU, OFF_H = OFF_WGLU + SZ_WGLU, OFF_XN = OFF_H + (size_t)M * DM * 4, OFF_BIG = OFF_XN + (size_t)M * DM * 2;
constexpr size_t OFF_MIX = OFF_XN, OFF_AX = OFF_XN, OFF_XC = OFF_AX + (size_t)M * 512, OFF_AA = OFF_XC + (size_t)M * 512;
static_assert(OFF_AA + (size_t)M * 768 <= OFF_BIG, "xn alias");
constexpr size_t OFF_ACT = OFF_BIG, OFF_PROJ = OFF_BIG, OFF_YR = OFF_PROJ + (size_t)M * DIN * 2, OFF_LA = OFF_YR + (size_t)M * 384 * 4, OFF_GX = OFF_LA + (size_t)M * 512,
    OFF_GG = OFF_GX + (size_t)M * 512, OFF_S5CS = OFF_GG + (size_t)M * 768, OFF_LCS = OFF_S5CS + (size_t)NB * 24 * NC * 128 * 4, OFF_END = OFF_LCS + (size_t)NB * NC * 256 * 2 * 4;
constexpr size_t OFF_GLR = OFF_LA;
static_assert((size_t)M * 768 <= (size_t)M * 1024, "glr alias");
static_assert(OFF_END <= 268435456ull, "workspace budget (256 MiB)");
static_assert(OFF_ACT + (size_t)M * DFF * 2 <= 268435456ull, "act");
constexpr size_t OOFF_RW = 0, OOFF_Z = (size_t)M * 3072;
static_assert(OOFF_Z + (size_t)M * 768 <= (size_t)NB * SEQ * DM * 4, "d_out scratch");

struct Params { const float* in[N_IN]; float* out; unsigned char* ws; };

DEVI float bf2f(bf16_t b) { return __uint_as_float(((unsigned)b) << 16); }
DEVI bf16_t f2bf(float f) { unsigned u = __float_as_uint(f); u += 0x7FFFu + ((u >> 16) & 1u); return (bf16_t)(u >> 16); }
DEVI float sigm(float x) { return 1.f / (1.f + __expf(-x)); }
DEVI float tanh_f(float x) { return 1.f - 2.f / (1.f + __expf(2.f * x)); }
DEVI float log1p_small(float x) { return x < 0.03f ? x * (1.f - x * (0.5f - x * (0.33333334f - 0.25f * x))) : __logf(1.f + x); }
DEVI float logsig8(float lm) { return 8.0f * (fminf(lm, 0.f) - log1p_small(__expf(-fabsf(lm)))); }
DEVI float gelu_t(float x) { const float u = 0.7978845608f * (x + 0.044715f * x * x * x); return x * sigm(2.f * u); }
DEVI float wave_sum(float v) {
#pragma unroll
    for (int o = 32; o; o >>= 1) v += __shfl_xor(v, o);
    return v; }
template <int CTRL> DEVI float dppf(float v) { return __int_as_float(__builtin_amdgcn_mov_dpp(__float_as_int(v), CTRL, 0xf, 0xf, true)); }
DEVI float red16(float v) { v += dppf<0xB1>(v); v += dppf<0x4E>(v); v += dppf<0x141>(v); v += dppf<0x140>(v); return v; }

struct EpiSwiglu {
    static constexpr bool PERM = false, AFTER_DRAIN = false; bf16_t* act;
    DEVI void operator()(const f32x4 (&acc)[2][2][4][2], const Unit& u, int wr, int wc, int fr, int fq) const {
        const int row0 = u.pm * 256 + wr * 64 + fr;
#pragma unroll
        for (int ai = 0; ai < 2; ++ai)
#pragma unroll
            for (int m = 0; m < 4; ++m) { bf16_t* rp = act + (size_t)(row0 + ai * 128 + m * 16) * DFF;
#pragma unroll
                for (int bj = 0; bj < 2; ++bj) { const int col = ((u.pn * 256 + bj * 128 + wc * 32) >> 1) + 4 * fq; const f32x4 g = acc[ai][bj][m][0], uu = acc[ai][bj][m][1];
                    float o[4];
#pragma unroll
                    for (int i = 0; i < 4; ++i) o[i] = g[i] * sigm(g[i]) * uu[i];
                    uint2 w; w.x = cvt_pk_bf16(o[0], o[1]); w.y = cvt_pk_bf16(o[2], o[3]); *(uint2*)(rp + col) = w; } }
    }
};
struct EpiResid {
    static constexpr bool PERM = false, AFTER_DRAIN = false; float* H; float scale;
    DEVI void operator()(const f32x4 (&acc)[2][2][4][2], const Unit& u, int wr, int wc, int fr, int fq) const {
        const int row0 = u.pm * 256 + wr * 64 + fr, col0 = u.pn * 256 + wc * 32 + 4 * fq;
#pragma unroll
        for (int ai = 0; ai < 2; ++ai)
#pragma unroll
            for (int m = 0; m < 4; ++m) { float* rp = H + (size_t)(row0 + ai * 128 + m * 16) * DM + col0;
#pragma unroll
                for (int bj = 0; bj < 2; ++bj)
#pragma unroll
                    for (int n = 0; n < 2; ++n) { f32x4* q = (f32x4*)(rp + bj * 128 + n * 16); f32x4 v = *q; v += acc[ai][bj][m][n] * scale; *q = v; } }
    }
};
struct EpiF16 {
    static constexpr bool PERM = false, AFTER_DRAIN = false; half_t* O0; half_t* O1; half_t* O2; int ld0, ld12, ncols, segw;
    DEVI void operator()(const f32x4 (&acc)[2][2][4][2], const Unit& u, int wr, int wc, int fr, int fq) const {
        const int row0 = u.pm * 256 + wr * 64 + fr;
#pragma unroll
        for (int bj = 0; bj < 2; ++bj) { const int cb = u.pn * 256 + bj * 128; if (cb >= ncols) continue;
            half_t* base = O0; int ld = ld0, lc = cb;
            if (segw) { const int seg = cb / segw; lc = cb - seg * segw; if (seg == 1) { base = O1; ld = ld12; } else if (seg == 2) { base = O2; ld = ld12; } }
            base += lc + wc * 32 + 4 * fq;
#pragma unroll
            for (int ai = 0; ai < 2; ++ai)
#pragma unroll
                for (int m = 0; m < 4; ++m) { half_t* rp = base + (size_t)(row0 + ai * 128 + m * 16) * ld;
#pragma unroll
                    for (int n = 0; n < 2; ++n) *(h4*)(rp + n * 16) = __builtin_convertvector(acc[ai][bj][m][n], h4); } }
    }
};
struct EpiAll {
    static constexpr bool PERM = false, AFTER_DRAIN = false; int mode; EpiSwiglu sw; EpiResid rs; EpiF16 f16;
    DEVI void operator()(const f32x4 (&acc)[2][2][4][2], const Unit& u, int wr, int wc, int fr, int fq) const {
        if (mode == 0) sw(acc, u, wr, wc, fr, fq); else if (mode == 1) rs(acc, u, wr, wc, fr, fq); else f16(acc, u, wr, wc, fr, fq);
    }
};
template <class Epi> DEVI void run_gemm(PG8_LAS unsigned char* lds, const bf16_t* A, const bf16_t* Bt, int N, int K, const Epi& E) {
    Gemm g; g.A = A; g.Bt = Bt; g.M = M; g.N = N; g.K = K;
    int bid_ = blockIdx.x; asm volatile("" : "+s"(bid_));
    StaticOrder S; S.init(M, N, (int)gridDim.x, bid_);
    pg8::gemm_phase<Epi, StaticOrder, false>(lds, g, S, E, nullptr);
}
#define LAUNDER_IDS int TIDX = threadIdx.x; asm volatile("" : "+v"(TIDX)); int BIDX = blockIdx.x; asm volatile("" : "+s"(BIDX))
template <class F> DEVI void conv_w(bf16_t* dst, int N, int K, float* tile, int rot, F src) { LAUNDER_IDS;
    const int ntk = K / 64, nt = (N / 64) * ntk; const int tx = TIDX & 63, ty = TIDX >> 6, rr = TIDX >> 3, kc = TIDX & 7;
    for (int t = (int)((BIDX + gridDim.x - (rot % (int)gridDim.x)) % gridDim.x); t < nt; t += gridDim.x) {
        const int r0 = (t / ntk) * 64, k0 = (t % ntk) * 64;
#pragma unroll
        for (int q = 0; q < 8; ++q) { const int k = ty + 8 * q; tile[k * 65 + tx] = src(k0 + k, r0 + tx); }
        __syncthreads();
        uint4 w; w.x = cvt_pk_bf16(tile[(kc * 8 + 0) * 65 + rr], tile[(kc * 8 + 1) * 65 + rr]); w.y = cvt_pk_bf16(tile[(kc * 8 + 2) * 65 + rr], tile[(kc * 8 + 3) * 65 + rr]);
        w.z = cvt_pk_bf16(tile[(kc * 8 + 4) * 65 + rr], tile[(kc * 8 + 5) * 65 + rr]); w.w = cvt_pk_bf16(tile[(kc * 8 + 6) * 65 + rr], tile[(kc * 8 + 7) * 65 + rr]);
        *(uint4*)(dst + (size_t)(r0 + rr) * K + k0 + kc * 8) = w;
        __syncthreads();
    }
}
DEVI void conv_ffn(const Params& p, int l, int which, float* tile) {
    const float* wg = p.in[which ? I_F2G : I_F1G] + (size_t)l * DM * DFF; const float* wu = p.in[which ? I_F2U : I_F1U] + (size_t)l * DM * DFF;
    const float* wd = p.in[which ? I_F2D : I_F1D] + (size_t)l * DFF * DM;
    const ptrdiff_t dgu = wu - wg;
    conv_w((bf16_t*)(p.ws + OFF_WGU), 2 * DFF, DM, tile, 0, [=](int k, int r) { const int q = r >> 5, s = r & 31; return wg[(s < 16 ? (ptrdiff_t)0 : dgu) + (ptrdiff_t)k * DFF + q * 16 + (s & 15)]; });
    conv_w((bf16_t*)(p.ws + OFF_WD), DM, DFF, tile, 128, [=](int k, int r) { return wd[(size_t)k * DM + r]; });
}
DEVI void conv_mix(const Params& p, int l, float* tile) {
    const float* win = p.in[I_WIN] + (size_t)l * DM * DIN; const float* wout = p.in[I_WOUT] + (size_t)l * DM * DM;
    const float* wup = p.in[I_WUP] + (size_t)l * 64 * 384; const float* aup = p.in[I_AUP] + (size_t)l * 64 * 384; const float* gup = p.in[I_GUP] + (size_t)l * 128 * 384;
    const float* wa = p.in[I_WA] + (size_t)l * 4 * 64 * 64; const float* wx = p.in[I_WX] + (size_t)l * 4 * 64 * 64; const float* glu = p.in[I_GLUW] + (size_t)l * 384 * 384;
    conv_w((bf16_t*)(p.ws + OFF_WIN), DIN, DM, tile, 64, [=](int k, int r) { return win[(size_t)k * DIN + r]; });
    conv_w((bf16_t*)(p.ws + OFF_WOUT), DM, DM, tile, 192, [=](int k, int r) { return wout[(size_t)k * DM + r]; });
    conv_w((bf16_t*)(p.ws + OFF_WLR), 1280, 256, tile, 0, [=](int k, int r) {
        float v = 0.f;
        if (r < 384) { if (k < 64) v = wup[k * 384 + r]; }
        else if (r < 768) { if (k >= 64 && k < 128) v = aup[(k - 64) * 384 + (r - 384)]; }
        else if (r < 1152) { if (k >= 128) v = gup[(k - 128) * 384 + (r - 768)]; }
        return v; });
    const ptrdiff_t dax = wx - wa;
    conv_w((bf16_t*)(p.ws + OFF_WLRU), 512, 256, tile, 80, [=](int k, int r) {
        const int rr2 = r & 255, hb = rr2 >> 6, j = rr2 & 63; float v = 0.f;
        if ((k >> 6) == hb) v = wa[(r < 256 ? (ptrdiff_t)0 : dax) + (hb * 64 + (k & 63)) * 64 + j];
        return v; });
    conv_w((bf16_t*)(p.ws + OFF_WGLU), 512, 384, tile, 112, [=](int k, int r) { return r < 384 ? glu[k * 384 + r] : 0.f; });
}

template <int MODE> DEVI void norm_phase(const Params& p, const float* gamma) { LAUNDER_IDS;
    const int wid = TIDX >> 6, lane = TIDX & 63, gw = BIDX * 8 + wid, nw = gridDim.x * 8;
    float* H = (float*)(p.ws + OFF_H); bf16_t* XN = (bf16_t*)(p.ws + OFF_XN);
    float4 gm[4];
#pragma unroll
    for (int i = 0; i < 4; ++i) gm[i] = *(const float4*)(gamma + i * 256 + lane * 4);
    for (int r = gw; r < M; r += nw) {
        const bool samp = r >= MP; const int b = r / LP, t = r - b * LP;
        const float* src;
        if (MODE == 0) src = samp ? p.in[I_XS] + (size_t)(r - MP) * DM : (t < NMETA ? p.in[I_META] + (size_t)t * DM : p.in[I_XP] + ((size_t)b * SEQ + (t - NMETA)) * DM);
        else src = H + (size_t)r * DM;
        float4 v[4]; float ss = 0.f;
#pragma unroll
        for (int i = 0; i < 4; ++i) { v[i] = *(const float4*)(src + i * 256 + lane * 4); ss += v[i].x * v[i].x + v[i].y * v[i].y + v[i].z * v[i].z + v[i].w * v[i].w; }
        ss = wave_sum(ss); const float rs = rsqrtf(ss * (1.0f / DM) + 1e-6f);
        if (MODE == 0) {
#pragma unroll
            for (int i = 0; i < 4; ++i) *(float4*)(H + (size_t)r * DM + i * 256 + lane * 4) = v[i];
        }
        if (MODE != 2) {
#pragma unroll
            for (int i = 0; i < 4; ++i) { uint2 w; w.x = cvt_pk_bf16(v[i].x * rs * gm[i].x, v[i].y * rs * gm[i].y); w.y = cvt_pk_bf16(v[i].z * rs * gm[i].z, v[i].w * rs * gm[i].w);
                *(uint2*)(XN + (size_t)r * DM + i * 256 + lane * 4) = w; }
        } else {
            float* dst = nullptr;
            if (samp) dst = p.out + O_YS + (size_t)(r - MP) * DM; else if (t >= NMETA) dst = p.out + O_YP + ((size_t)b * SEQ + (t - NMETA)) * DM;
            if (dst) {
#pragma unroll
                for (int i = 0; i < 4; ++i) { float4 o; o.x = v[i].x * rs * gm[i].x; o.y = v[i].y * rs * gm[i].y; o.z = v[i].z * rs * gm[i].z; o.w = v[i].w * rs * gm[i].w; *(float4*)(dst + i * 256 + lane * 4) = o; }
            }
        }
    }
}

template <int CARRY> DEVI void s5_item(const Params& p, int l, int g, int seq, int j, float* ldsH, int lane) {
    constexpr bool OUT = CARRY != 0;
    const half_t* PROJ = (const half_t*)(p.ws + OFF_PROJ); float* CS = (float*)(p.ws + OFF_S5CS); bf16_t* Z = (bf16_t*)((unsigned char*)p.out + OOFF_Z);
    const int n = lane, lg = l * 24 + g;
    const float lr = p.in[I_LAMRE][lg * 64 + n], li = p.in[I_LAMIM][lg * 64 + n], dt = expf(p.in[I_LOGDT][lg]);
    const float mag = expf(lr * dt); float sn, cs; sincosf(li * dt, &sn, &cs); const float abr = mag * cs, abi = mag * sn;
    const float den = lr * lr + li * li, fre = ((abr - 1.f) * lr + abi * li) / den, fim = (abi * lr - (abr - 1.f) * li) / den;
    float Br[16], Bi[16];
    { const float4* br = (const float4*)(p.in[I_BRE] + (size_t)(lg * 64 + n) * 16); const float4* bi = (const float4*)(p.in[I_BIM] + (size_t)(lg * 64 + n) * 16);
#pragma unroll
      for (int q = 0; q < 4; ++q) { const float4 a = br[q], b = bi[q];
          Br[4 * q + 0] = fre * a.x - fim * b.x; Bi[4 * q + 0] = fre * b.x + fim * a.x; Br[4 * q + 1] = fre * a.y - fim * b.y; Bi[4 * q + 1] = fre * b.y + fim * a.y;
          Br[4 * q + 2] = fre * a.z - fim * b.z; Bi[4 * q + 2] = fre * b.z + fim * a.z; Br[4 * q + 3] = fre * a.w - fim * b.w; Bi[4 * q + 3] = fre * b.w + fim * a.w; } }
    const int tt = lane & 15, cq = lane >> 4;
    float Cm[32]; float dsk[4];
    if (OUT) {
        const float* cre = p.in[I_CRE] + (size_t)(lg * 16 + tt) * 64; const float* cim = p.in[I_CIM] + (size_t)(lg * 16 + tt) * 64;
#pragma unroll
        for (int s = 0; s < 16; ++s) { Cm[s] = cre[4 * s + cq]; Cm[16 + s] = -cim[4 * s + cq]; }
#pragma unroll
        for (int i = 0; i < 4; ++i) dsk[i] = p.in[I_S5D][l * 384 + g * 16 + cq * 4 + i];
    }
    int row0, ntok; float hr = 0.f, hi = 0.f;
    if (CARRY == 2) { row0 = MP + seq; ntok = 1; hr = p.in[I_S5RE][((size_t)(l * NS + seq) * 24 + g) * 64 + n]; hi = p.in[I_S5IM][((size_t)(l * NS + seq) * 24 + g) * 64 + n]; }
    else { row0 = seq * LP + j * LC; ntok = LC; }
    if (CARRY == 1) {
        float Lr = 1.f, Li = 0.f;
        for (int i = 0; i < LC; ++i) { const float a = Lr * abr - Li * abi, b = Lr * abi + Li * abr; Lr = a; Li = b; }
        const float* cs0 = CS + (size_t)((seq * 24 + g) * NC) * 128 + n;
        for (int i0 = 0; i0 < j; i0 += 8) { float er[8], ei[8];
#pragma unroll
            for (int u = 0; u < 8; ++u) { const int ii = min(i0 + u, j - 1); er[u] = cs0[(size_t)ii * 128]; ei[u] = cs0[(size_t)ii * 128 + 64]; }
#pragma unroll
            for (int u = 0; u < 8; ++u) { const bool ok = (i0 + u) < j; const float mr = ok ? Lr : 1.f, mi = ok ? Li : 0.f, ar = ok ? er[u] : 0.f, ai = ok ? ei[u] : 0.f;
                const float a = hr * mr - hi * mi + ar, b = hr * mi + hi * mr + ai; hr = a; hi = b; } }
    }
    for (int tb = 0; tb < ntok; tb += 16) {
        const int ti = min(tb + tt, ntok - 1); const size_t row = (size_t)(row0 + ti);
        const h4 uh = *(const h4*)(PROJ + row * DIN + g * 16 + cq * 4);
        float uf[4];
#pragma unroll
        for (int i = 0; i < 4; ++i) uf[i] = (float)uh[i];
#pragma unroll
        for (int t2 = 0; t2 < 16; ++t2) {
            if (tb + t2 < ntok) {
                float xr = 0.f, xi = 0.f;
#pragma unroll
                for (int c = 0; c < 16; ++c) { const float uc = __int_as_float(__builtin_amdgcn_readlane(__float_as_int(uf[c & 3]), (c >> 2) * 16 + t2)); xr = fmaf(Br[c], uc, xr); xi = fmaf(Bi[c], uc, xi); }
                const float a = abr * hr - abi * hi + xr, b = abr * hi + abi * hr + xi; hr = a; hi = b;
            }
            if (OUT) { ldsH[n * 17 + t2] = hr; ldsH[(64 + n) * 17 + t2] = hi; }
        }
        if (OUT) {
            __builtin_amdgcn_fence(__ATOMIC_RELEASE, "wavefront"); __builtin_amdgcn_wave_barrier(); __builtin_amdgcn_fence(__ATOMIC_ACQUIRE, "wavefront");
            f32x4 acc = (f32x4){0.f, 0.f, 0.f, 0.f};
#pragma unroll
            for (int s = 0; s < 32; ++s) acc = __builtin_amdgcn_mfma_f32_16x16x4f32(Cm[s], ldsH[(4 * s + cq) * 17 + tt], acc, 0, 0, 0);
            float z[4];
#pragma unroll
            for (int i = 0; i < 4; ++i) z[i] = gelu_t(acc[i] + dsk[i] * uf[i]);
            if (tb + tt < ntok) { uint2 w; w.x = cvt_pk_bf16(z[0], z[1]); w.y = cvt_pk_bf16(z[2], z[3]); *(uint2*)(Z + row * 384 + g * 16 + cq * 4) = w; }
            __builtin_amdgcn_fence(__ATOMIC_RELEASE, "wavefront"); __builtin_amdgcn_wave_barrier(); __builtin_amdgcn_fence(__ATOMIC_ACQUIRE, "wavefront");
        }
    }
    if (CARRY == 0) { float* o = CS + (size_t)((seq * 24 + g) * NC + j) * 128 + n; o[0] = hr; o[64] = hi; }
    if (CARRY == 1 && j == NC - 1) { p.out[O_PS5RE + ((size_t)(l * NB + seq) * 24 + g) * 64 + n] = hr; p.out[O_PS5IM + ((size_t)(l * NB + seq) * 24 + g) * 64 + n] = hi; }
    if (CARRY == 2) { p.out[O_SS5RE + ((size_t)(l * NS + seq) * 24 + g) * 64 + n] = hr; p.out[O_SS5IM + ((size_t)(l * NS + seq) * 24 + g) * 64 + n] = hi; }
}

DEVI float rw_prev(const Params& p, int l, const half_t* PROJ, int row, int jcol) {
    if (row >= MP) return p.in[I_SHIFT][(size_t)(l * NS + (row - MP)) * RPROJ + jcol];
    const int t = row % LP; return t == 0 ? 0.f : (float)PROJ[(size_t)(row - 1) * DIN + 384 + jcol];
}

DEVI void phase_m1a(const Params& p, int l, float* lds) { LAUNDER_IDS;
    const half_t* PROJ = (const half_t*)(p.ws + OFF_PROJ); bf16_t* AX = (bf16_t*)(p.ws + OFF_AX); bf16_t* XC = (bf16_t*)(p.ws + OFF_XC);
    const float* mu = p.in[I_MU] + l * RPROJ; const float* cw = p.in[I_CW] + l * 4 * 256; const float* cb = p.in[I_CB] + l * 256;
    const size_t gsz = (size_t)gridDim.x * blockDim.x;
    for (size_t idx = (size_t)BIDX * blockDim.x + TIDX; idx < (size_t)M * 256; idx += gsz) {
        const int row = (int)(idx >> 8), c = (int)(idx & 255); const bool samp = row >= MP; const int b = row / LP, t = row - b * LP, s = row - MP;
        const half_t* pr = PROJ + (size_t)row * DIN;
        { const int j = 1152 + c; const float pv = (float)pr[384 + j]; const float pp = rw_prev(p, l, PROJ, row, j); const float xm = pv + (pp - pv) * mu[j];
          const float o = c < 64 ? tanh_f(xm) : (c < 128 ? xm : sigm(xm)); AX[(size_t)row * 256 + c] = f2bf(o); }
        const float x0 = (float)pr[1792 + c]; float xm1, xm2, xm3;
        if (samp) { const float* c0 = p.in[I_CONV] + (size_t)(l * NS + s) * 3 * 256 + c; xm3 = c0[0]; xm2 = c0[256]; xm1 = c0[512]; }
        else { xm1 = t >= 1 ? (float)pr[1792 + c - DIN] : 0.f; xm2 = t >= 2 ? (float)pr[1792 + c - 2 * DIN] : 0.f; xm3 = t >= 3 ? (float)pr[1792 + c - 3 * DIN] : 0.f; }
        const float xc = cb[c] + cw[c] * xm3 + cw[256 + c] * xm2 + cw[512 + c] * xm1 + cw[768 + c] * x0;
        XC[(size_t)row * 256 + c] = f2bf(xc);
        if (samp) {
            float* so = p.out + O_SSHIFT + (size_t)(l * NS + s) * RPROJ;
            for (int j = c; j < RPROJ; j += 256) so[j] = (float)pr[384 + j];
            float* co = p.out + O_SCONV + (size_t)(l * NS + s) * 3 * 256 + c; co[0] = xm2; co[256] = xm1; co[512] = x0;
        } else if (t >= LP - 3) {
            p.out[O_PCONV + ((size_t)(l * NB + b) * 3 + (t - (LP - 3))) * 256 + c] = x0;
            if (t == LP - 1) { float* so = p.out + O_PSHIFT + (size_t)(l * NB + b) * RPROJ; for (int j = c; j < RPROJ; j += 256) so[j] = (float)pr[384 + j]; }
        }
    }
    const int wid = TIDX >> 6, lane = TIDX & 63;
    for (int it = BIDX * 8 + wid; it < NB * 24 * NC; it += gridDim.x * 8) { const int j = it % NC, sg = it / NC; s5_item<0>(p, l, sg % 24, sg / 24, j, lds, lane); }
}

DEVI void phase_m1c(const Params& p, int l) { LAUNDER_IDS;
    const half_t* PROJ = (const half_t*)(p.ws + OFF_PROJ); const half_t* AA = (const half_t*)(p.ws + OFF_AA); half_t* RW = (half_t*)((unsigned char*)p.out + OOFF_RW);
    const float* mu = p.in[I_MU] + l * RPROJ; const int wid = TIDX >> 6, lane = TIDX & 63;
    for (int it = BIDX * 8 + wid; it < M * RH; it += gridDim.x * 8) {
        const int row = it / RH, h = it - row * RH, col = h * 64 + lane;
        const float pv = (float)PROJ[(size_t)row * DIN + 768 + col]; const float pp = rw_prev(p, l, PROJ, row, 384 + col);
        const float kraw = pv + (pp - pv) * mu[384 + col]; const float a = sigm(p.in[I_A0][l * 384 + col] + (float)AA[(size_t)row * 384 + col]);
        const float kkr = kraw * p.in[I_KK][l * 384 + col]; const float ss = wave_sum(kkr * kkr); const float kk = kkr / fmaxf(sqrtf(ss), 1e-12f);
        const float kp = kraw * (1.f + (a - 1.f) * p.in[I_KA][l * 384 + col]);
        half_t* o = RW + (size_t)row * 1536 + col; const float e = sigm(p.in[I_W0][l * 384 + col] + (float)o[0]) * 0.6065306597f;
        o[0] = (half_t)(1.f - __expf(-e)); o[384] = (half_t)kp; o[768] = (half_t)kk; o[1152] = (half_t)(kk * a);
    }
    const half_t* LA = (const half_t*)(p.ws + OFF_LA); const half_t* GX = (const half_t*)(p.ws + OFF_GX); float* LCS = (float*)(p.ws + OFF_LCS);
    const float* cw = p.in[I_CW] + l * 4 * 256; const float* cb = p.in[I_CB] + l * 256;
    for (int id = BIDX * blockDim.x + TIDX; id < NB * NC * 256; id += gridDim.x * blockDim.x) {
        const int c = id & 255, bj = id >> 8, j = bj % NC, b = bj / NC, t0 = j * LC; const size_t row0 = (size_t)b * LP + t0;
        const half_t* px = PROJ + row0 * DIN + 1792 + c;
        float xm1 = t0 >= 1 ? (float)px[-DIN] : 0.f, xm2 = t0 >= 2 ? (float)px[-2 * DIN] : 0.f, xm3 = t0 >= 3 ? (float)px[-3 * DIN] : 0.f;
        const float w0 = cw[c], w1 = cw[256 + c], w2 = cw[512 + c], w3 = cw[768 + c], bb = cb[c];
        const float lmv = p.in[I_LAM][l * 256 + c], ls8 = logsig8(lmv), bav = p.in[I_BA][l * 256 + c], bxv = p.in[I_BX][l * 256 + c];
        float A = 1.f, hh = 0.f;
        for (int tt = 0; tt < LC; ++tt) { const float x0 = (float)px[(size_t)tt * DIN]; const float la = sigm((float)LA[(row0 + tt) * 256 + c] + bav) * ls8, gx = sigm((float)GX[(row0 + tt) * 256 + c] + bxv);
            const float xc = bb + w0 * xm3 + w1 * xm2 + w2 * xm1 + w3 * x0; const float a = __expf(la); const float bm = sqrtf(fmaxf(1.f - __expf(2.f * la), 0.f));
            hh = a * hh + bm * gx * xc; A *= a; xm3 = xm2; xm2 = xm1; xm1 = x0; }
        LCS[(size_t)id * 2] = A; LCS[(size_t)id * 2 + 1] = hh;
    }
}
DEVI float rwkv_step(float (&S)[4], const h4 om, const h4 kp, const h4 kk, const h4 ka, const float (&r)[4], float v) {
    float sa = 0.f;
#pragma unroll
    for (int i = 0; i < 4; ++i) sa = fmaf(-S[i], (float)kk[i], sa);
    float tmp[4];
#pragma unroll
    for (int i = 0; i < 4; ++i) { tmp[i] = fmaf(-(float)om[i], S[i], S[i]); tmp[i] = fmaf(v, (float)kp[i], tmp[i]); }
    sa = red16(sa);
    float y = 0.f;
#pragma unroll
    for (int i = 0; i < 4; ++i) { S[i] = fmaf(sa, (float)ka[i], tmp[i]); y = fmaf(S[i], r[i], y); }
    return red16(y);
}
DEVI void rwkv_prompt(const Params& p, int l, int b, int h, int rg, int lane) {
    const int vrow = rg * 4 + (lane >> 4), kq = lane & 15;
    const half_t* RWp = (const half_t*)((const unsigned char*)p.out + OOFF_RW) + (size_t)(b * LP) * 1536 + h * 64 + kq * 4;
    const half_t* PRr = (const half_t*)(p.ws + OFF_PROJ) + (size_t)(b * LP) * DIN + 384 + h * 64 + kq * 4;
    const half_t* PRv = (const half_t*)(p.ws + OFF_PROJ) + (size_t)(b * LP) * DIN + 384 + 768 + h * 64 + vrow;
    float* yout = (float*)(p.ws + OFF_YR) + (size_t)(b * LP) * 384 + h * 64 + vrow;
    const float* mu = p.in[I_MU] + l * RPROJ;
    float mur[4];
#pragma unroll
    for (int i = 0; i < 4; ++i) mur[i] = mu[h * 64 + kq * 4 + i];
    const float muv = mu[768 + h * 64 + vrow];
    float S[4] = {0.f, 0.f, 0.f, 0.f}, pr_r[4] = {0.f, 0.f, 0.f, 0.f}, pr_v = 0.f;
    h4 om[8], kp[8], kk[8], ka[8], rr[8]; half_t vv[8];
#define RW_LD(u, t) do { const half_t* a_ = RWp + (size_t)(t) * 1536; om[u] = *(const h4*)a_; kp[u] = *(const h4*)(a_ + 384); kk[u] = *(const h4*)(a_ + 768); ka[u] = *(const h4*)(a_ + 1152); \
        rr[u] = *(const h4*)(PRr + (size_t)(t) * DIN); vv[u] = PRv[(size_t)(t) * DIN]; } while (0)
#pragma unroll
    for (int u = 0; u < 8; ++u) RW_LD(u, u);
    for (int t = 0; t < LP; t += 8) {
#pragma unroll
        for (int u = 0; u < 8; ++u) {
            const h4 c_om = om[u], c_kp = kp[u], c_kk = kk[u], c_ka = ka[u], c_r = rr[u]; const float c_v = (float)vv[u];
            const int tn = min(t + 8 + u, LP - 1); RW_LD(u, tn);
            float r[4];
#pragma unroll
            for (int i = 0; i < 4; ++i) { const float x = (float)c_r[i]; r[i] = x + (pr_r[i] - x) * mur[i]; pr_r[i] = x; }
            const float v = c_v + (pr_v - c_v) * muv; pr_v = c_v;
            const float y = rwkv_step(S, c_om, c_kp, c_kk, c_ka, r, v);
            if (kq == 0) yout[(size_t)(t + u) * 384] = y;
        }
    }
#undef RW_LD
    *(float4*)(p.out + O_PRWKV + ((size_t)((l * NB + b) * RH + h) * 64 + vrow) * 64 + kq * 4) = make_float4(S[0], S[1], S[2], S[3]);
}
DEVI void rwkv_sample(const Params& p, int l, int s, int h, int rg, int lane) {
    const int vrow = rg * 4 + (lane >> 4), kq = lane & 15; const size_t row = (size_t)(MP + s);
    const half_t* RWp = (const half_t*)((const unsigned char*)p.out + OOFF_RW) + row * 1536 + h * 64 + kq * 4;
    const half_t* PR = (const half_t*)(p.ws + OFF_PROJ) + row * DIN + 384;
    const float* mu = p.in[I_MU] + l * RPROJ; const float* sh = p.in[I_SHIFT] + (size_t)(l * NS + s) * RPROJ;
    const size_t so = ((size_t)((l * NS + s) * RH + h) * 64 + vrow) * 64 + kq * 4;
    const float4 s4 = *(const float4*)(p.in[I_RWKV] + so); float S[4] = {s4.x, s4.y, s4.z, s4.w};
    const h4 c_r = *(const h4*)(PR + h * 64 + kq * 4); float r[4];
#pragma unroll
    for (int i = 0; i < 4; ++i) { const float x = (float)c_r[i]; r[i] = x + (sh[h * 64 + kq * 4 + i] - x) * mu[h * 64 + kq * 4 + i]; }
    const float xv = (float)PR[768 + h * 64 + vrow]; const float v = xv + (sh[768 + h * 64 + vrow] - xv) * mu[768 + h * 64 + vrow];
    const float y = rwkv_step(S, *(const h4*)RWp, *(const h4*)(RWp + 384), *(const h4*)(RWp + 768), *(const h4*)(RWp + 1152), r, v);
    if (kq == 0) ((float*)(p.ws + OFF_YR))[row * 384 + h * 64 + vrow] = y;
    *(float4*)(p.out + O_SRWKV + so) = make_float4(S[0], S[1], S[2], S[3]);
}
DEVI void lru_item(const Params& p, int l, bool samp, int seq, int j, int c) {
    const half_t* PROJ = (const half_t*)(p.ws + OFF_PROJ); const half_t* LA = (const half_t*)(p.ws + OFF_LA); const half_t* GX = (const half_t*)(p.ws + OFF_GX);
    const float* LCS = (const float*)(p.ws + OFF_LCS); bf16_t* MIX = (bf16_t*)(p.ws + OFF_MIX);
    const float* cw = p.in[I_CW] + l * 4 * 256; const float w0 = cw[c], w1 = cw[256 + c], w2 = cw[512 + c], w3 = cw[768 + c], bb = p.in[I_CB][l * 256 + c];
    const float lmv = p.in[I_LAM][l * 256 + c], ls8 = logsig8(lmv), bav = p.in[I_BA][l * 256 + c], bxv = p.in[I_BX][l * 256 + c];
    float hh = 0.f, xm1, xm2, xm3; size_t row0; int ntok;
    if (samp) { row0 = (size_t)(MP + seq); ntok = 1; hh = p.in[I_LRU][(size_t)(l * NS + seq) * 256 + c];
        const float* c0 = p.in[I_CONV] + (size_t)(l * NS + seq) * 3 * 256 + c; xm3 = c0[0]; xm2 = c0[256]; xm1 = c0[512]; }
    else { const int t0 = j * LC; row0 = (size_t)seq * LP + t0; ntok = LC; const half_t* px = PROJ + row0 * DIN + 1792 + c;
        xm1 = t0 >= 1 ? (float)px[-DIN] : 0.f; xm2 = t0 >= 2 ? (float)px[-2 * DIN] : 0.f; xm3 = t0 >= 3 ? (float)px[-3 * DIN] : 0.f;
        const float* cs = LCS + ((size_t)(seq * NC) * 256 + c) * 2;
        for (int i0 = 0; i0 < j; i0 += 8) { float2 e[8];
#pragma unroll
            for (int u = 0; u < 8; ++u) { const int ii = min(i0 + u, j - 1); e[u] = *(const float2*)(cs + (size_t)ii * 512); }
#pragma unroll
            for (int u = 0; u < 8; ++u) { const bool ok = (i0 + u) < j; hh = ok ? fmaf(hh, e[u].x, e[u].y) : hh; } }
    }
    for (int tt = 0; tt < ntok; ++tt) { const size_t row = row0 + tt; const half_t* pr = PROJ + row * DIN;
        const float x0 = (float)pr[1792 + c], gl = (float)pr[2048 + c], la = sigm((float)LA[row * 256 + c] + bav) * ls8, gx = sigm((float)GX[row * 256 + c] + bxv);
        const float xc = bb + w0 * xm3 + w1 * xm2 + w2 * xm1 + w3 * x0; const float a = __expf(la); const float bm = sqrtf(fmaxf(1.f - __expf(2.f * la), 0.f));
        hh = a * hh + bm * gx * xc; xm3 = xm2; xm2 = xm1; xm1 = x0;
        MIX[row * DM + 768 + c] = f2bf(hh * gelu_t(gl)); }
    if (samp) p.out[O_SLRU + (size_t)(l * NS + seq) * 256 + c] = hh;
    else if (j == NC - 1) p.out[O_PLRU + (size_t)(l * NB + seq) * 256 + c] = hh;
}
constexpr int N_S5P = NB * 24 * NC, N_S5S = NS * 24, N_LRP = NB * NC * 4, N_LRS = NS * 4, N_RWS = NS * RH * 16;
DEVI void phase_m2(const Params& p, int l, float* lds) { LAUNDER_IDS;
    const int wid = TIDX >> 6, lane = TIDX & 63;
    if (wid < 3) {
        const int xcd = BIDX & 7, slot = BIDX >> 3;
        for (int q = slot * 3 + wid; q < 96; q += (gridDim.x >> 3) * 3) rwkv_prompt(p, l, xcd, q >> 4, q & 15, lane);
    } else {
        float* ldsH = lds + (wid - 3) * (128 * 17);
        const int nwk = gridDim.x * 5;
        for (int it = BIDX * 5 + (wid - 3); it < N_S5P + N_S5S + N_LRP + N_LRS + N_RWS; it += nwk) {
            int k = it;
            if (k < N_S5P) { const int j = k % NC, sg = k / NC; s5_item<1>(p, l, sg % 24, sg / 24, j, ldsH, lane); continue; }
            k -= N_S5P;
            if (k < N_S5S) { s5_item<2>(p, l, k % 24, k / 24, 0, ldsH, lane); continue; }
            k -= N_S5S;
            if (k < N_LRP) { const int cq = k & 3, bj = k >> 2; lru_item(p, l, false, bj / NC, bj % NC, cq * 64 + lane); continue; }
            k -= N_LRP;
            if (k < N_LRS) { lru_item(p, l, true, k >> 2, 0, (k & 3) * 64 + lane); continue; }
            k -= N_LRS;
            { const int rg = k & 15, sh = k >> 4; rwkv_sample(p, l, sh / RH, sh % RH, rg, lane); }
        }
    }
}
DEVI void phase_m3_fin(const Params& p, int l) { LAUNDER_IDS;
    const half_t* PROJ = (const half_t*)(p.ws + OFF_PROJ); const half_t* RW = (const half_t*)((const unsigned char*)p.out + OOFF_RW); const half_t* GG = (const half_t*)(p.ws + OFF_GG);
    const float* YR = (const float*)(p.ws + OFF_YR); bf16_t* MIX = (bf16_t*)(p.ws + OFF_MIX); const float* mu = p.in[I_MU] + l * RPROJ;
    const int wid = TIDX >> 6, lane = TIDX & 63;
    for (int it = BIDX * 8 + wid; it < M * RH; it += gridDim.x * 8) {
        const int row = it / RH, h = it - row * RH, col = h * 64 + lane;
        const float y = YR[(size_t)row * 384 + col]; const float mean = wave_sum(y) * (1.f / 64.f); const float d = y - mean; const float var = wave_sum(d * d) * (1.f / 64.f);
        const float yn = d * rsqrtf(var + 64e-5f) * p.in[I_LNW][l * 384 + col] + p.in[I_LNB][l * 384 + col];
        const float pr = (float)PROJ[(size_t)row * DIN + 384 + col]; const float r = pr + (rw_prev(p, l, PROJ, row, col) - pr) * mu[col];
        const float pv = (float)PROJ[(size_t)row * DIN + 384 + 768 + col]; const float v = pv + (rw_prev(p, l, PROJ, row, 768 + col) - pv) * mu[768 + col];
        const float kp = (float)RW[(size_t)row * 1536 + 384 + col];
        const float bonus = wave_sum(r * kp * p.in[I_RK][l * 384 + col]) * v;
        MIX[(size_t)row * DM + 384 + col] = f2bf((yn + bonus) * (float)GG[(size_t)row * 384 + col]);
        const float z = bf2f(((const bf16_t*)((const unsigned char*)p.out + OOFF_Z))[(size_t)row * 384 + col]);
        MIX[(size_t)row * DM + col] = f2bf(z * sigm((float)((const half_t*)(p.ws + OFF_GLR))[(size_t)row * 384 + col] + p.in[I_GLUB][l * 384 + col]));
    }
}

constexpr int PH_PER_LAYER = 15, N_PHASES = 1 + 2 * PH_PER_LAYER;
__global__ void __launch_bounds__(512, 2) mega(Params p_arg, int ph_begin, int ph_end) {
    extern __shared__ __attribute__((aligned(16))) unsigned char shm[];
    PG8_LAS unsigned char* lds = (PG8_LAS unsigned char*)shm; float* ldsf = (float*)shm;
    for (int ph = ph_begin; ph < ph_end; ++ph) {
        if (ph > ph_begin) cg::this_grid().sync();
        const Params* pq = (const Params*)__builtin_amdgcn_kernarg_segment_ptr(); asm volatile("" : "+s"(pq)); const Params& p = *pq;
        bf16_t* WGU = (bf16_t*)(p.ws + OFF_WGU); bf16_t* WD = (bf16_t*)(p.ws + OFF_WD); bf16_t* XN = (bf16_t*)(p.ws + OFF_XN); bf16_t* ACT = (bf16_t*)(p.ws + OFF_ACT);
        float* H = (float*)(p.ws + OFF_H);
        if (ph == 0) { conv_ffn(p, 0, 0, ldsf); conv_mix(p, 0, ldsf); norm_phase<0>(p, p.in[I_F1N]); continue; }
        const int l = (ph - 1) / PH_PER_LAYER, s = (ph - 1) % PH_PER_LAYER;
        int ngemm = 0; const bf16_t* gA = nullptr; const bf16_t* gB = nullptr; int gN = 0, gK = 0; EpiAll E; E.mode = 0;
        E.sw.act = ACT; E.rs.H = H; E.rs.scale = 0.5f; E.f16.O0 = nullptr; E.f16.O1 = nullptr; E.f16.O2 = nullptr; E.f16.ld0 = 0; E.f16.ld12 = 0; E.f16.ncols = 0; E.f16.segw = 0;
        switch (s) {
        case 0: case 12: ngemm = 1; gA = XN; gB = WGU; gN = 2 * DFF; gK = DM; E.mode = 0; break;
        case 1: case 13: ngemm = 1; gA = ACT; gB = WD; gN = DM; gK = DFF; E.mode = 1; break;
        case 10: ngemm = 1; gA = (const bf16_t*)(p.ws + OFF_MIX); gB = (const bf16_t*)(p.ws + OFF_WOUT); gN = DM; gK = DM; E.mode = 1; E.rs.scale = 1.0f; break;
        case 2: conv_ffn(p, l, 1, ldsf); norm_phase<1>(p, p.in[I_MIXN] + l * DM); break;
        case 3: ngemm = 1; gA = XN; gB = (const bf16_t*)(p.ws + OFF_WIN); gN = DIN; gK = DM; E.mode = 2; E.f16.O0 = (half_t*)(p.ws + OFF_PROJ); E.f16.ld0 = DIN; E.f16.ncols = DIN; break;
        case 4: phase_m1a(p, l, ldsf); break;
        case 5: ngemm = 2; gA = (const bf16_t*)(p.ws + OFF_AX); gB = (const bf16_t*)(p.ws + OFF_WLR); gN = 1280; gK = 256; E.mode = 2;
            E.f16.O0 = (half_t*)((unsigned char*)p.out + OOFF_RW); E.f16.O1 = (half_t*)(p.ws + OFF_AA); E.f16.O2 = (half_t*)(p.ws + OFF_GG); E.f16.ld0 = 1536; E.f16.ld12 = 384; E.f16.ncols = 1152; E.f16.segw = 384; break;
        case 6: phase_m1c(p, l); break;
        case 7: phase_m2(p, l, ldsf); break;
        case 8: ngemm = 1; gA = (const bf16_t*)((const unsigned char*)p.out + OOFF_Z); gB = (const bf16_t*)(p.ws + OFF_WGLU); gN = 512; gK = 384; E.mode = 2;
            E.f16.O0 = (half_t*)(p.ws + OFF_GLR); E.f16.ld0 = 384; E.f16.ncols = 384; break;
        case 9: phase_m3_fin(p, l); break;
        case 11: norm_phase<1>(p, p.in[I_F2N] + l * DM); break;
        case 14: if (l == 1) norm_phase<2>(p, p.in[I_FINN]); else { conv_ffn(p, l + 1, 0, ldsf); conv_mix(p, l + 1, ldsf); norm_phase<1>(p, p.in[I_F1N] + (l + 1) * DM); } break;
        }
        for (int gi = 0; gi < ngemm; ++gi) {
            if (gi == 1) {
                gA = (const bf16_t*)(p.ws + OFF_XC); gB = (const bf16_t*)(p.ws + OFF_WLRU); gN = 512; gK = 256;
                E.f16.O0 = (half_t*)(p.ws + OFF_LA); E.f16.O1 = (half_t*)(p.ws + OFF_GX); E.f16.O2 = E.f16.O1; E.f16.ld0 = 256; E.f16.ld12 = 256; E.f16.ncols = 512; E.f16.segw = 256; }
            run_gemm(lds, gA, gB, gN, gK, E);
        }
    }
}

extern "C" void kernel_launch(void* const* d_in, const int* in_sizes, int n_in, void* d_out, int out_size, void* d_ws, size_t ws_size, hipStream_t stream) {
    constexpr size_t kDynLds = pg8::STAGE_BYTES;
    static int grid_blocks = 0;
    if (!grid_blocks) {
        hipFuncSetAttribute((const void*)mega, hipFuncAttributeMaxDynamicSharedMemorySize, (int)kDynLds);
        int dev = 0, cus = 0, per_cu = 0; hipGetDevice(&dev); hipDeviceGetAttribute(&cus, hipDeviceAttributeMultiprocessorCount, dev);
        hipOccupancyMaxActiveBlocksPerMultiprocessor(&per_cu, mega, 512, kDynLds);
        if (per_cu < 1) per_cu = 1;
        grid_blocks = cus;
        if (grid_blocks % 8) grid_blocks -= grid_blocks % 8;
    }
    Params p{};
    for (int i = 0; i < N_IN; ++i) p.in[i] = (const float*)d_in[i];
    p.out = (float*)d_out; p.ws = (unsigned char*)d_ws;
#ifdef MULTI_LAUNCH
    for (int ph = 0; ph < N_PHASES; ++ph) hipLaunchKernelGGL(mega, dim3(grid_blocks), dim3(512), kDynLds, stream, p, ph, ph + 1);
#else
    int b = 0, e = N_PHASES; void* args[] = {&p, &b, &e};
    hipError_t err = hipLaunchCooperativeKernel((void*)mega, dim3(grid_blocks), dim3(512), args, kDynLds, stream);
    if (err != hipSuccess) fprintf(stderr, "cooperative launch failed: %s (grid %d)\n", hipGetErrorString(err), grid_blocks);
#endif
}
```

```cpp
#include <hip/hip_runtime.h>
#include <hip/hip_cooperative_groups.h>
#include <cstdio>
namespace cg = cooperative_groups;
namespace pg8 {
#define PG8_LAS __attribute__((address_space(3)))
typedef unsigned short bf16_t;
typedef short bf16x8 __attribute__((ext_vector_type(8)));
typedef float f32x4 __attribute__((ext_vector_type(4)));
typedef unsigned u32x4 __attribute__((ext_vector_type(4)));
constexpr int BM = 256, BK = 64, HALF = 128, HTB = HALF * BK * 2  , STAGE_BYTES = 8 * HTB, NXCD = 8, WGM = 8;

__host__ __device__ __forceinline__ int lds_byte(int r, int c) { const int st = (r >> 4) * 2 + (c >> 5), rr = r & 15, cc = c & 31, ob = rr * 64 + cc * 2; return st * 1024 + (ob ^ (((ob >> 9) & 1) << 5)); }
__host__ __device__ __forceinline__ void stage_rc(int b, int& R, int& C) { const int st = b / 1024, sb = b % 1024, swz = sb ^ (((sb >> 9) & 1) << 5); R = (st >> 1) * 16 + swz / 64; C = (st & 1) * 32 + (swz % 64) / 2; }
__host__ __device__ __forceinline__ int perm32(int rho) { const int n = rho >> 4, i = rho & 15; return 8 * (i >> 2) + 4 * n + (i & 3); }

struct Unit { int pm, pn; };
struct Gemm { const bf16_t* A; const bf16_t* Bt; int M, N, K; int ld; size_t a_pm, b_pm; int perm; };

struct StaticOrder {
    int nM, nN, nwg, G, c;
    __host__ __device__ void init(int M, int N, int G_, int c_) { nM = M / BM; nN = N / BM; nwg = nM * nN; G = G_; c = c_; }
    __host__ __device__ bool next(int i, Unit& u) const {
        const long L = (long)i * G + c; if (L >= nwg) return false;
        int wgid = (int)L; { const int q = nwg / NXCD, r = nwg % NXCD, xcd = wgid % NXCD, off = wgid / NXCD; wgid = (xcd < r ? xcd * (q + 1) : r * (q + 1) + (xcd - r) * q) + off; }
        const int nig = WGM * nN, gid = wgid / nig, fm = gid * WGM, gsz = (nM - fm) < WGM ? (nM - fm) : WGM;
        u.pm = fm + ((wgid % nig) % gsz); u.pn = (wgid % nig) / gsz; return true;
    }
    __device__ __forceinline__ void a_ready(const Unit&) const {}
    __device__ __forceinline__ void done(const Unit&) const {}
};
__device__ __forceinline__ unsigned cvt_pk_bf16(float lo, float hi) { unsigned r; asm volatile("v_cvt_pk_bf16_f32 %0, %1, %2" : "=v"(r) : "v"(lo), "v"(hi)); return r; }
template <class Epi, class Sched, bool STAMP = false>
__device__ __forceinline__ void gemm_phase(PG8_LAS unsigned char* lds, const Gemm g, const Sched& S, const Epi& E, unsigned long long* stamps) {
    int tid_ = threadIdx.x; asm volatile("" : "+v"(tid_));
    const int tid = tid_, wid = __builtin_amdgcn_readfirstlane(tid >> 6), lane = tid & 63, wr = wid >> 2, wc = wid & 3, fr = lane & 15, fq = lane >> 4;
    const int K = g.K, nt = K / BK;
    int ts_lo = 0, ts_hi = 0, nts = 0; const unsigned long long rt_entry = STAMP ? (unsigned long long)wall_clock64() : 0ull;
#define PG8_STAMP() do { if (STAMP && wid == 0 && nts < 64) { const unsigned long long _c = (unsigned long long)clock64(); \
        ts_lo = (lane == nts) ? (int)(unsigned)_c : ts_lo; ts_hi = (lane == nts) ? (int)(unsigned)(_c >> 32) : ts_hi; ++nts; } } while (0)
    PG8_STAMP();
    unsigned voffA[2], voffB[2];
#pragma unroll
    for (int i = 0; i < 2; ++i) { int R, C; stage_rc(tid * 16 + i * 8192, R, C); const int Rb = g.perm ? ((R & ~31) + perm32(R & 31)) : R;
        voffA[i] = (unsigned)(R * g.ld + C) * 2u; voffB[i] = (unsigned)(Rb * g.ld + C) * 2u; }
    const size_t kstep = (size_t)(BK * 2);
    const size_t hstep = (size_t)HALF * g.ld * 2;
    const size_t tstep = 2 * hstep;
    const unsigned ldsw = (unsigned)wid * 1024u;
    const int aoff = lds_byte(wr * 64 + fr, fq * 8), boff = lds_byte(wc * 32 + fr, fq * 8);
#define PG8_SA(b, h) (((b) * 2 + (h)) * HTB)
#define PG8_SB(b, h) ((4 + (b) * 2 + (h)) * HTB)
#define PG8_STAGE(bufoff, gbase, voff) do { _Pragma("unroll") for (int _i = 0; _i < 2; ++_i) \
        __builtin_amdgcn_global_load_lds((const unsigned*)((const char*)(gbase) + (voff)[_i]), (PG8_LAS unsigned*)(lds + (bufoff) + ldsw + _i * 8192), 16, 0, 0); } while (0)
#define PG8_LDA(dst, b, h) do { _Pragma("unroll") for (int m = 0; m < 4; ++m) _Pragma("unroll") for (int k = 0; k < 2; ++k) dst[m][k] = *(const PG8_LAS bf16x8*)(lds + PG8_SA(b, h) + aoff + m * 2048 + k * 1024); } while (0)
#define PG8_LDB(dst, b, h) do { _Pragma("unroll") for (int n = 0; n < 2; ++n) _Pragma("unroll") for (int k = 0; k < 2; ++k) dst[n][k] = *(const PG8_LAS bf16x8*)(lds + PG8_SB(b, h) + boff + n * 2048 + k * 1024); } while (0)
#define PG8_MMA(ai, bj, At, Bt) do { __builtin_amdgcn_s_setprio(1); _Pragma("unroll") for (int m = 0; m < 4; ++m) _Pragma("unroll") for (int n = 0; n < 2; ++n) _Pragma("unroll") for (int k = 0; k < 2; ++k) \
        acc[ai][bj][m][n] = __builtin_amdgcn_mfma_f32_16x16x32_bf16(Bt[n][k], At[m][k], acc[ai][bj][m][n], 0, 0, 0); __builtin_amdgcn_s_setprio(0); } while (0)
#define PG8_WAIT_V(n) asm volatile("s_waitcnt vmcnt(" #n ")" ::: "memory")
#define PG8_WAIT_L(n) asm volatile("s_waitcnt lgkmcnt(" #n ")" ::: "memory")
#define PG8_BAR __builtin_amdgcn_s_barrier()
#define PG8_SCHED __builtin_amdgcn_sched_barrier(0)
    Unit cur, nxt; int ui = 0;
    if (!S.next(0, cur)) return;
    f32x4 acc[2][2][4][2];
#pragma unroll
    for (int a = 0; a < 2; ++a)
#pragma unroll
        for (int b = 0; b < 2; ++b)
#pragma unroll
            for (int m = 0; m < 4; ++m)
#pragma unroll
                for (int n = 0; n < 2; ++n) acc[a][b][m][n] = (f32x4){0.f, 0.f, 0.f, 0.f};
    bf16x8 At[4][2], B0[2][2], B1[2][2];
    const char* cA = (const char*)g.A + (size_t)cur.pm * g.a_pm; const char* cB = (const char*)g.Bt + (size_t)cur.pn * tstep + (size_t)cur.pm * g.b_pm;
    S.a_ready(cur);
    PG8_STAGE(PG8_SB(0, 0), cB, voffB); PG8_STAGE(PG8_SA(0, 0), cA, voffA); PG8_STAGE(PG8_SB(0, 1), cB + hstep, voffB); PG8_STAGE(PG8_SA(0, 1), cA + hstep, voffA);
    if (wr == 1) PG8_BAR;
    PG8_WAIT_V(4); PG8_BAR;
    PG8_STAGE(PG8_SB(1, 0), cB + kstep, voffB); PG8_STAGE(PG8_SA(1, 0), cA + kstep, voffA); PG8_STAGE(PG8_SB(1, 1), cB + hstep + kstep, voffB);
    PG8_WAIT_V(6); PG8_BAR;
    PG8_STAMP();
    for (;;) {
        const bool has_next = S.next(ui + 1, nxt);
        const char* nA = has_next ? (const char*)g.A + (size_t)nxt.pm * g.a_pm : cA; const char* nB = has_next ? (const char*)g.Bt + (size_t)nxt.pn * tstep + (size_t)nxt.pm * g.b_pm : cB;
        for (int t = 0; t < nt; t += 2) {
            const bool last = (t == nt - 2);
            const char* a1 = cA + (size_t)(t + 1) * kstep;
            const char* a2 = last ? nA : cA + (size_t)(t + 2) * kstep; const char* b2 = last ? nB : cB + (size_t)(t + 2) * kstep;
            const char* a3 = a2 + kstep; const char* b3 = b2 + kstep;
            if (last && has_next) S.a_ready(nxt);
            PG8_LDB(B0, 0, 0); PG8_SCHED; PG8_LDA(At, 0, 0); PG8_STAGE(PG8_SA(1, 1), a1 + hstep, voffA);
            PG8_WAIT_L(8); PG8_BAR; PG8_WAIT_L(0); PG8_MMA(0, 0, At, B0); PG8_BAR; PG8_SCHED;
            PG8_LDB(B1, 0, 1); PG8_STAGE(PG8_SB(0, 0), b2, voffB);
            PG8_BAR; PG8_WAIT_L(0); PG8_MMA(0, 1, At, B1); PG8_BAR;
            PG8_LDA(At, 0, 1); PG8_STAGE(PG8_SA(0, 0), a2, voffA);
            PG8_BAR; PG8_WAIT_L(0); PG8_MMA(1, 0, At, B0); PG8_BAR; PG8_SCHED;
            PG8_STAGE(PG8_SB(0, 1), b2 + hstep, voffB);
            PG8_WAIT_V(6); PG8_BAR; PG8_MMA(1, 1, At, B1); PG8_BAR;
            PG8_LDB(B0, 1, 0); PG8_SCHED; PG8_LDA(At, 1, 0); PG8_STAGE(PG8_SA(0, 1), a2 + hstep, voffA);
            PG8_WAIT_L(8); PG8_BAR; PG8_WAIT_L(0); PG8_MMA(0, 0, At, B0); PG8_BAR; PG8_SCHED;
            PG8_LDB(B1, 1, 1); PG8_STAGE(PG8_SB(1, 0), b3, voffB);
            PG8_BAR; PG8_WAIT_L(0); PG8_MMA(0, 1, At, B1); PG8_BAR;
            PG8_LDA(At, 1, 1); PG8_STAGE(PG8_SA(1, 0), a3, voffA);
            PG8_BAR; PG8_WAIT_L(0); PG8_MMA(1, 0, At, B0); PG8_BAR; PG8_SCHED;
            PG8_STAGE(PG8_SB(1, 1), b3 + hstep, voffB);
            PG8_WAIT_V(6); PG8_BAR; PG8_MMA(1, 1, At, B1); PG8_BAR;
        }
        PG8_STAMP();
        if constexpr (!Epi::AFTER_DRAIN) { E(acc, cur, wr, wc, fr, fq); S.done(cur); }
        PG8_STAMP();
        if (!has_next) break;
#pragma unroll
        for (int a = 0; a < 2; ++a)
#pragma unroll
            for (int b = 0; b < 2; ++b)
#pragma unroll
                for (int m = 0; m < 4; ++m)
#pragma unroll
                    for (int n = 0; n < 2; ++n) acc[a][b][m][n] = (f32x4){0.f, 0.f, 0.f, 0.f};
        cur = nxt; cA = nA; cB = nB; ++ui;
    }
    PG8_WAIT_V(0);
    if (wr == 0) PG8_BAR;
    PG8_BAR;
    if constexpr (Epi::AFTER_DRAIN) { E.fused(acc, cur, wr, wc, fr, fq, lds, wid, lane); S.done(cur); }
    PG8_STAMP();
    if (STAMP && wid == 0) { stamps[lane] = lane < nts ? (((unsigned long long)(unsigned)ts_hi << 32) | (unsigned)ts_lo) : 0ull;
        if (lane == 62) stamps[62] = rt_entry; if (lane == 63) stamps[63] = (unsigned long long)wall_clock64(); }
#undef PG8_STAMP
#undef PG8_SA
#undef PG8_SB
#undef PG8_STAGE
#undef PG8_LDA
#undef PG8_LDB
#undef PG8_MMA
#undef PG8_WAIT_V
#undef PG8_WAIT_L
#undef PG8_BAR
#undef PG8_SCHED
}
}
using pg8::bf16_t; using pg8::f32x4; using pg8::Unit; using pg8::Gemm; using pg8::StaticOrder; using pg8::cvt_pk_bf16;
#define DEVI __device__ __forceinline__
typedef _Float16 half_t;
typedef _Float16 h4 __attribute__((ext_vector_type(4)));
typedef _Float16 h8 __attribute__((ext_vector_type(8)));
typedef __fp16 fp2_t __attribute__((ext_vector_type(2)));

constexpr int DM = 1024, DFF = 2816, NB = 8, NMETA = 16, SEQ = 2048, LP = SEQ + NMETA, MP = NB * LP, NS = 128, M = MP + NS;
constexpr int DIN = 2304, S5G = 24, RH = 6, RPROJ = 1408;
constexpr int NC = 43, LC = 48;
static_assert(NC * LC == LP, "chunking");
static_assert(LP % 12 == 0 && MP + 12 <= M, "scan prefetch depth / over-read stays inside the row range");
static_assert(M % 256 == 0, "rows");
enum { I_XP = 0, I_XS, I_S5RE, I_S5IM, I_RWKV, I_SHIFT, I_LRU, I_CONV, I_META, I_F1N, I_F1G, I_F1U, I_F1D, I_MIXN, I_WIN,
       I_LAMRE, I_LAMIM, I_LOGDT, I_BRE, I_BIM, I_CRE, I_CIM, I_S5D, I_GLUW, I_GLUB,
       I_MU, I_W0, I_WUP, I_A0, I_AUP, I_GUP, I_KK, I_KA, I_RK, I_LNW, I_LNB,
       I_CW, I_CB, I_WA, I_BA, I_WX, I_BX, I_LAM, I_WOUT, I_F2N, I_F2G, I_F2U, I_F2D, I_FINN, N_IN };
constexpr size_t O_YP = 0, O_YS = O_YP + (size_t)NB * SEQ * DM, O_PS5RE = O_YS + (size_t)NS * DM, O_PS5IM = O_PS5RE + 2 * NB * 24 * 64,
    O_PRWKV = O_PS5IM + 2 * NB * 24 * 64, O_PSHIFT = O_PRWKV + (size_t)2 * NB * 6 * 4096, O_PLRU = O_PSHIFT + 2 * NB * 1408, O_PCONV = O_PLRU + 2 * NB * 256,
    O_SS5RE = O_PCONV + 2 * NB * 3 * 256, O_SS5IM = O_SS5RE + (size_t)2 * NS * 24 * 64, O_SRWKV = O_SS5IM + (size_t)2 * NS * 24 * 64,
    O_SSHIFT = O_SRWKV + (size_t)2 * NS * 6 * 4096, O_SLRU = O_SSHIFT + (size_t)2 * NS * 1408, O_SCONV = O_SLRU + (size_t)2 * NS * 256, O_END = O_SCONV + (size_t)2 * NS * 3 * 256;
static_assert(O_END == 25090048, "out size");
constexpr size_t SZ_WGU = 5632ull * 1024 * 2, SZ_WD = 1024ull * 2816 * 2, SZ_WIN = 2304ull * 1024 * 2, SZ_WOUT = 1024ull * 1024 * 2, SZ_WLR = 1280ull * 256 * 2,
    SZ_WLRU = 512ull * 256 * 2, SZ_WGLU = 512ull * 384 * 2;
constexpr size_t OFF_WGU = 0, OFF_WD = OFF_WGU + SZ_WGU, OFF_WIN = OFF_WD + SZ_WD, OFF_WOUT = OFF_WIN + SZ_WIN, OFF_WLR = OFF_WOUT + SZ_WOUT, OFF_WLRU = OFF_WLR + SZ_WLR,
    OFF_WGLU = OFF_WLRU + SZ_WLRU, OFF_H = OFF_WGLU + SZ_WGLU, OFF_XN = OFF_H + (size_t)M * DM * 4, OFF_BIG = OFF_XN + (size_t)M * DM * 2;
constexpr size_t OFF_MIX = OFF_XN, OFF_AX = OFF_XN, OFF_XC = OFF_AX + (size_t)M * 512, OFF_AA = OFF_XC + (size_t)M * 512;
static_assert(OFF_AA + (size_t)M * 768 <= OFF_BIG, "xn alias");
constexpr size_t OFF_ACT = OFF_BIG, OFF_PROJ = OFF_BIG, OFF_YR = OFF_PROJ + (size_t)M * DIN * 2, OFF_LA = OFF_YR + (size_t)M * 384 * 4, OFF_GX = OFF_LA + (size_t)M * 512,
    OFF_GG = OFF_GX + (size_t)M * 512, OFF_S5CS = OFF_GG + (size_t)M * 768, OFF_LCS = OFF_S5CS + (size_t)NB * 24 * NC * 128 * 4, OFF_END = OFF_LCS + (size_t)NB * NC * 256 * 2 * 4;
constexpr size_t OFF_PART = OFF_ACT + (size_t)M * DFF * 2;
static_assert(OFF_PART + 11ull * 256 * 1024 * 4 <= OFF_S5CS, "part");
constexpr size_t OFF_RL = OFF_WGU;
static_assert((size_t)M * 768 <= SZ_WGU + SZ_WD, "rl alias");
constexpr size_t OFF_GLR = OFF_LA;
static_assert((size_t)M * 768 <= (size_t)M * 1024, "glr alias");
constexpr size_t OFF_BAR = (OFF_END + 255) & ~(size_t)255, BAR_BYTES = 3456 * 4;
static_assert(OFF_BAR + BAR_BYTES <= 268435456ull, "workspace budget (256 MiB)");
static_assert(OFF_ACT + (size_t)M * DFF * 2 <= 268435456ull, "act");
constexpr size_t OOFF_RW = 0, OOFF_Z = (size_t)M * 3072;
static_assert(OOFF_Z + (size_t)M * 768 <= (size_t)NB * SEQ * DM * 4, "d_out scratch");

struct Params { const float* in[N_IN]; float* out; unsigned char* ws; };

DEVI float bf2f(bf16_t b) { return __uint_as_float(((unsigned)b) << 16); }
DEVI bf16_t f2bf(float f) { unsigned u = __float_as_uint(f); u += 0x7FFFu + ((u >> 16) & 1u); return (bf16_t)(u >> 16); }
DEVI float sigm(float x) { return __builtin_amdgcn_rcpf(1.f + __expf(-x)); }
DEVI float tanh_f(float x) { return 1.f - 2.f * __builtin_amdgcn_rcpf(1.f + __expf(2.f * x)); }
DEVI float log1p_small(float x) { return x < 0.03f ? x * (1.f - x * (0.5f - x * (0.33333334f - 0.25f * x))) : __logf(1.f + x); }
DEVI float logsig8(float lm) { return 8.0f * (fminf(lm, 0.f) - log1p_small(__expf(-fabsf(lm)))); }
DEVI float gelu_t(float x) { const float u = 0.7978845608f * (x + 0.044715f * x * x * x); return x * sigm(2.f * u); }
DEVI float wave_sum(float v) {
#pragma unroll
    for (int o = 32; o; o >>= 1) v += __shfl_xor(v, o);
    return v; }
template <int CTRL> DEVI float dppf(float v) { return __int_as_float(__builtin_amdgcn_mov_dpp(__float_as_int(v), CTRL, 0xf, 0xf, true)); }
DEVI float red16(float v) { v += dppf<0xB1>(v); v += dppf<0x4E>(v); v += dppf<0x141>(v); v += dppf<0x140>(v); return v; }

struct EpiSwiglu {
    static constexpr bool PERM = true, AFTER_DRAIN = false; bf16_t* act;
    DEVI void operator()(const f32x4 (&acc)[2][2][4][2], const Unit& u, int wr, int wc, int fr, int fq) const {
        const int row0 = u.pm * 256 + wr * 64 + fr, col = u.pn * 128 + wc * 32 + 8 * fq;
#pragma unroll
        for (int ai = 0; ai < 2; ++ai)
#pragma unroll
            for (int m = 0; m < 4; ++m) { bf16_t* rp = act + (size_t)(row0 + ai * 128 + m * 16) * DFF + col;
                float o[8];
#pragma unroll
                for (int n = 0; n < 2; ++n) { const f32x4 g = acc[ai][0][m][n], uu = acc[ai][1][m][n];
#pragma unroll
                    for (int i = 0; i < 4; ++i) o[4 * n + i] = g[i] * sigm(g[i]) * uu[i]; }
                uint4 w; w.x = cvt_pk_bf16(o[0], o[1]); w.y = cvt_pk_bf16(o[2], o[3]); w.z = cvt_pk_bf16(o[4], o[5]); w.w = cvt_pk_bf16(o[6], o[7]); *(uint4*)rp = w; }
    }
};
struct EpiResid {
    static constexpr bool PERM = false, AFTER_DRAIN = false; float* H; float scale; int row_base, pm_mul, atomic;
    DEVI void operator()(const f32x4 (&acc)[2][2][4][2], const Unit& u, int wr, int wc, int fr, int fq) const {
        const int row0 = row_base + u.pm * 256 * pm_mul + wr * 64 + fr, col0 = u.pn * 256 + wc * 32 + 4 * fq;
#pragma unroll
        for (int ai = 0; ai < 2; ++ai)
#pragma unroll
            for (int m = 0; m < 4; ++m) { float* rp = H + (size_t)(row0 + ai * 128 + m * 16) * DM + col0;
#pragma unroll
                for (int bj = 0; bj < 2; ++bj)
#pragma unroll
                    for (int n = 0; n < 2; ++n) { float* q = rp + bj * 128 + n * 16; const f32x4 a = acc[ai][bj][m][n] * scale;
                        if (atomic) *(f32x4*)q = a;
                        else { f32x4 v = *(f32x4*)q; v += a; *(f32x4*)q = v; } } }
    }
};
struct EpiF16 {
    static constexpr bool PERM = true, AFTER_DRAIN = false; half_t* O0; half_t* O1; half_t* O2; int ld0, ld12, ncols, segw, cs0;
    DEVI void operator()(const f32x4 (&acc)[2][2][4][2], const Unit& u, int wr, int wc, int fr, int fq) const {
        const int row0 = u.pm * 256 + wr * 64 + fr;
#pragma unroll
        for (int bj = 0; bj < 2; ++bj) { const int cb = u.pn * 256 + bj * 128; if (cb >= ncols) continue;
            half_t* base = O0; int ld = ld0, lc = cb, cm = cs0;
            if (segw) { const int seg = cb / segw; lc = cb - seg * segw; if (seg == 1) { base = O1; ld = ld12; cm = 1; } else if (seg == 2) { base = O2; ld = ld12; cm = 1; } }
            base += (lc + wc * 32 + 8 * fq) * cm;
#pragma unroll
            for (int ai = 0; ai < 2; ++ai)
#pragma unroll
                for (int m = 0; m < 4; ++m) { half_t* rp = base + (size_t)(row0 + ai * 128 + m * 16) * ld;
                    const h4 v0 = __builtin_convertvector(acc[ai][bj][m][0], h4), v1 = __builtin_convertvector(acc[ai][bj][m][1], h4);
                    if (cm == 1) *(h8*)rp = __builtin_shufflevector(v0, v1, 0, 1, 2, 3, 4, 5, 6, 7);
                    else { *(h4*)rp = v0; *(h4*)(rp + 4 * cm) = v1; } } }
    }
};
struct EpiAll {
    static constexpr bool PERM = false, AFTER_DRAIN = false; int mode; EpiSwiglu sw; EpiResid rs; EpiF16 f16;
    DEVI void operator()(const f32x4 (&acc)[2][2][4][2], const Unit& u, int wr, int wc, int fr, int fq) const {
        if (mode == 0) sw(acc, u, wr, wc, fr, fq); else if (mode == 1) rs(acc, u, wr, wc, fr, fq); else f16(acc, u, wr, wc, fr, fq);
    }
};
template <class Epi> DEVI void run_gemm(PG8_LAS unsigned char* lds, const bf16_t* A, const bf16_t* Bt, int Mrows, int N, int K, int ld, size_t a_pm, size_t b_pm, int perm, const Epi& E) {
    Gemm g; g.A = A; g.Bt = Bt; g.M = Mrows; g.N = N; g.K = K; g.ld = ld; g.a_pm = a_pm; g.b_pm = b_pm; g.perm = perm;
    int bid_ = blockIdx.x; asm volatile("" : "+s"(bid_));
    StaticOrder S; S.init(Mrows, N, (int)gridDim.x, bid_);
    pg8::gemm_phase<Epi, StaticOrder, false>(lds, g, S, E, nullptr);
}
#define LAUNDER_IDS int TIDX = threadIdx.x; asm volatile("" : "+v"(TIDX)); int BIDX = blockIdx.x; asm volatile("" : "+s"(BIDX))
template <class F> DEVI void conv_w(bf16_t* dst, int N, int K, float* tile, int rot, F src) { LAUNDER_IDS;
    const int ntk = K / 64, nt = (N / 64) * ntk; const int tx = TIDX & 63, ty = TIDX >> 6, rr = TIDX >> 3, kc = TIDX & 7;
    const int G = (int)gridDim.x;
    for (int t = (int)((BIDX + G - (rot % G)) % G); t < nt; t += 2 * G) {
        const int t2 = t + G; const bool has2 = t2 < nt;
        const int r0 = (t / ntk) * 64, k0 = (t % ntk) * 64, r1 = has2 ? (t2 / ntk) * 64 : r0, k1 = has2 ? (t2 % ntk) * 64 : k0;
        float va[8], vb[8];
#pragma unroll
        for (int q = 0; q < 8; ++q) { va[q] = src(k0 + ty + 8 * q, r0 + tx); vb[q] = src(k1 + ty + 8 * q, r1 + tx); }
#pragma unroll
        for (int q = 0; q < 8; ++q) { tile[(ty + 8 * q) * 65 + tx] = va[q]; tile[64 * 65 + (ty + 8 * q) * 65 + tx] = vb[q]; }
        __syncthreads();
#pragma unroll
        for (int h = 0; h < 2; ++h) { if (h == 1 && !has2) break; const float* tl = tile + h * 64 * 65;
            uint4 w; w.x = cvt_pk_bf16(tl[(kc * 8 + 0) * 65 + rr], tl[(kc * 8 + 1) * 65 + rr]); w.y = cvt_pk_bf16(tl[(kc * 8 + 2) * 65 + rr], tl[(kc * 8 + 3) * 65 + rr]);
            w.z = cvt_pk_bf16(tl[(kc * 8 + 4) * 65 + rr], tl[(kc * 8 + 5) * 65 + rr]); w.w = cvt_pk_bf16(tl[(kc * 8 + 6) * 65 + rr], tl[(kc * 8 + 7) * 65 + rr]);
            *(uint4*)(dst + (size_t)((h ? r1 : r0) + rr) * K + (h ? k1 : k0) + kc * 8) = w; }
        __syncthreads();
    }
}
DEVI void conv_ffn(const Params& p, int l, int which, float* tile) {
    const float* wg = p.in[which ? I_F2G : I_F1G] + (size_t)l * DM * DFF; const float* wu = p.in[which ? I_F2U : I_F1U] + (size_t)l * DM * DFF;
    const float* wd = p.in[which ? I_F2D : I_F1D] + (size_t)l * DFF * DM;
    const ptrdiff_t dgu = wu - wg;
    conv_w((bf16_t*)(p.ws + OFF_WGU), 2 * DFF, DM, tile, 0, [=](int k, int r) { const int q = r >> 8, s = r & 255; return __builtin_nontemporal_load(wg + ((s < 128 ? (ptrdiff_t)0 : dgu) + (ptrdiff_t)k * DFF + q * 128 + (s & 127))); });
    conv_w((bf16_t*)(p.ws + OFF_WD), DM, DFF, tile, 128, [=](int k, int r) { return __builtin_nontemporal_load(wd + ((size_t)k * DM + r)); });
}
DEVI void conv_mix(const Params& p, int l, float* tile) {
    const float* win = p.in[I_WIN] + (size_t)l * DM * DIN; const float* wout = p.in[I_WOUT] + (size_t)l * DM * DM;
    const float* wup = p.in[I_WUP] + (size_t)l * 64 * 384; const float* aup = p.in[I_AUP] + (size_t)l * 64 * 384; const float* gup = p.in[I_GUP] + (size_t)l * 128 * 384;
    const float* wa = p.in[I_WA] + (size_t)l * 4 * 64 * 64; const float* wx = p.in[I_WX] + (size_t)l * 4 * 64 * 64; const float* glu = p.in[I_GLUW] + (size_t)l * 384 * 384;
    conv_w((bf16_t*)(p.ws + OFF_WIN), DIN, DM, tile, 64, [=](int k, int r) { return __builtin_nontemporal_load(win + ((size_t)k * DIN + r)); });
    conv_w((bf16_t*)(p.ws + OFF_WOUT), DM, DM, tile, 192, [=](int k, int r) { return __builtin_nontemporal_load(wout + ((size_t)k * DM + r)); });
    conv_w((bf16_t*)(p.ws + OFF_WLR), 1280, 256, tile, 0, [=](int k, int r) {
        float v = 0.f;
        if (r < 384) { if (k < 64) v = wup[k * 384 + r]; }
        else if (r < 768) { if (k >= 64 && k < 128) v = aup[(k - 64) * 384 + (r - 384)]; }
        else if (r < 1152) { if (k >= 128) v = gup[(k - 128) * 384 + (r - 768)]; }
        return v; });
    const ptrdiff_t dax = wx - wa;
    conv_w((bf16_t*)(p.ws + OFF_WLRU), 512, 256, tile, 80, [=](int k, int r) {
        const int rr2 = r & 255, hb = rr2 >> 6, j = rr2 & 63; float v = 0.f;
        if ((k >> 6) == hb) v = wa[(r < 256 ? (ptrdiff_t)0 : dax) + (hb * 64 + (k & 63)) * 64 + j];
        return v; });
    conv_w((bf16_t*)(p.ws + OFF_WGLU), 512, 384, tile, 112, [=](int k, int r) { return r < 384 ? glu[k * 384 + r] : 0.f; });
}

template <int MODE> DEVI void norm_phase(const Params& p, const float* gamma, int nsl = 0, const half_t* D = nullptr, float dscale = 0.f) { LAUNDER_IDS;
    const int wid = TIDX >> 6, lane = TIDX & 63, gw = BIDX * 8 + wid, nw = gridDim.x * 8;
    float* H = (float*)(p.ws + OFF_H); bf16_t* XN = (bf16_t*)(p.ws + OFF_XN);
    float4 gm[4];
#pragma unroll
    for (int i = 0; i < 4; ++i) gm[i] = *(const float4*)(gamma + i * 256 + lane * 4);
    auto srcp = [&](int r) -> const float* {
        const bool samp = r >= MP; const int b = r / LP, t = r - b * LP;
        if (MODE == 0) return samp ? p.in[I_XS] + (size_t)(r - MP) * DM : (t < NMETA ? p.in[I_META] + (size_t)t * DM : p.in[I_XP] + ((size_t)b * SEQ + (t - NMETA)) * DM);
        return H + (size_t)r * DM; };
    auto process = [&](int r, float4 (&v)[4], const h4 (&d)[4]) {
        const bool samp = r >= MP; const int b = r / LP, t = r - b * LP;
        float ss = 0.f;
        if (MODE != 0 && D && r < 16384) {
#pragma unroll
            for (int i = 0; i < 4; ++i) { v[i].x = fmaf(dscale, (float)d[i][0], v[i].x); v[i].y = fmaf(dscale, (float)d[i][1], v[i].y); v[i].z = fmaf(dscale, (float)d[i][2], v[i].z); v[i].w = fmaf(dscale, (float)d[i][3], v[i].w);
                if (MODE == 1) *(float4*)(H + (size_t)r * DM + i * 256 + lane * 4) = v[i]; }
        }
#pragma unroll
        for (int i = 0; i < 4; ++i) ss += v[i].x * v[i].x + v[i].y * v[i].y + v[i].z * v[i].z + v[i].w * v[i].w;
        if (MODE != 0 && nsl > 0 && r >= 16384) {
            const float* part = (const float*)(p.ws + OFF_PART) + (size_t)(r - 16384) * DM; ss = 0.f;
            for (int sl = 0; sl < nsl; ++sl) {
#pragma unroll
                for (int i = 0; i < 4; ++i) { const float4 q = *(const float4*)(part + (size_t)sl * 256 * DM + i * 256 + lane * 4); v[i].x += q.x; v[i].y += q.y; v[i].z += q.z; v[i].w += q.w; } }
#pragma unroll
            for (int i = 0; i < 4; ++i) { ss += v[i].x * v[i].x + v[i].y * v[i].y + v[i].z * v[i].z + v[i].w * v[i].w; if (MODE == 1) *(float4*)(H + (size_t)r * DM + i * 256 + lane * 4) = v[i]; }
        }
        ss = wave_sum(ss); const float rs = rsqrtf(ss * (1.0f / DM) + 1e-6f);
        if (MODE == 0) {
#pragma unroll
            for (int i = 0; i < 4; ++i) *(float4*)(H + (size_t)r * DM + i * 256 + lane * 4) = v[i];
        }
        if (MODE != 2) {
#pragma unroll
            for (int i = 0; i < 4; ++i) { uint2 w; w.x = cvt_pk_bf16(v[i].x * rs * gm[i].x, v[i].y * rs * gm[i].y); w.y = cvt_pk_bf16(v[i].z * rs * gm[i].z, v[i].w * rs * gm[i].w);
                *(uint2*)(XN + (size_t)r * DM + i * 256 + lane * 4) = w; }
        } else {
            float* dst = nullptr;
            if (samp) dst = p.out + O_YS + (size_t)(r - MP) * DM; else if (t >= NMETA) dst = p.out + O_YP + ((size_t)b * SEQ + (t - NMETA)) * DM;
            if (dst) {
#pragma unroll
                for (int i = 0; i < 4; ++i) { float4 o; o.x = v[i].x * rs * gm[i].x; o.y = v[i].y * rs * gm[i].y; o.z = v[i].z * rs * gm[i].z; o.w = v[i].w * rs * gm[i].w; *(float4*)(dst + i * 256 + lane * 4) = o; }
            }
        }
    };
    for (int r = gw; r < M; r += 2 * nw) {
        const int r2 = r + nw; const bool has2 = r2 < M;
        const float* s1 = srcp(r); const float* s2 = srcp(has2 ? r2 : r);
        float4 va[4], vb[4]; h4 da[4], db[4];
#pragma unroll
        for (int i = 0; i < 4; ++i) { const f32x4 ta = __builtin_nontemporal_load((const f32x4*)(s1 + i * 256 + lane * 4)), tb = __builtin_nontemporal_load((const f32x4*)(s2 + i * 256 + lane * 4));
            va[i] = make_float4(ta[0], ta[1], ta[2], ta[3]); vb[i] = make_float4(tb[0], tb[1], tb[2], tb[3]); da[i] = (h4){0, 0, 0, 0}; db[i] = da[i]; }
        if (MODE != 0 && D) {
            const int ra = r < 16384 ? r : 0, rb = (has2 && r2 < 16384) ? r2 : 0;
#pragma unroll
            for (int i = 0; i < 4; ++i) { da[i] = __builtin_nontemporal_load((const h4*)(D + (size_t)ra * DM + i * 256 + lane * 4)); db[i] = __builtin_nontemporal_load((const h4*)(D + (size_t)rb * DM + i * 256 + lane * 4)); }
        }
        process(r, va, da);
        if (has2) process(r2, vb, db);
    }
}

template <int CARRY> DEVI void s5_item(const Params& p, int l, int g, int seq, int j, float* ldsH, int lane) {
    constexpr bool OUT = CARRY != 0;
    const half_t* PROJ = (const half_t*)(p.ws + OFF_PROJ); float* CS = (float*)(p.ws + OFF_S5CS); bf16_t* Z = (bf16_t*)((unsigned char*)p.out + OOFF_Z);
    const int n = lane, lg = l * 24 + g;
    const float lr = p.in[I_LAMRE][lg * 64 + n], li = p.in[I_LAMIM][lg * 64 + n], dt = expf(p.in[I_LOGDT][lg]);
    const float mag = expf(lr * dt); float sn, cs; sincosf(li * dt, &sn, &cs); const float abr = mag * cs, abi = mag * sn;
    const float den = lr * lr + li * li, fre = ((abr - 1.f) * lr + abi * li) / den, fim = (abi * lr - (abr - 1.f) * li) / den;
    float Br[16], Bi[16];
    { const float4* br = (const float4*)(p.in[I_BRE] + (size_t)(lg * 64 + n) * 16); const float4* bi = (const float4*)(p.in[I_BIM] + (size_t)(lg * 64 + n) * 16);
#pragma unroll
      for (int q = 0; q < 4; ++q) { const float4 a = br[q], b = bi[q];
          Br[4 * q + 0] = fre * a.x - fim * b.x; Bi[4 * q + 0] = fre * b.x + fim * a.x; Br[4 * q + 1] = fre * a.y - fim * b.y; Bi[4 * q + 1] = fre * b.y + fim * a.y;
          Br[4 * q + 2] = fre * a.z - fim * b.z; Bi[4 * q + 2] = fre * b.z + fim * a.z; Br[4 * q + 3] = fre * a.w - fim * b.w; Bi[4 * q + 3] = fre * b.w + fim * a.w; } }
    fp2_t Bpr[8], Bpi[8];
#pragma unroll
    for (int c2 = 0; c2 < 8; ++c2) { Bpr[c2] = (fp2_t){(__fp16)Br[2 * c2], (__fp16)Br[2 * c2 + 1]}; Bpi[c2] = (fp2_t){(__fp16)Bi[2 * c2], (__fp16)Bi[2 * c2 + 1]}; }
    const int tt = lane & 15, cq = lane >> 4;
    float Cm[32]; float dsk[4];
    if (OUT) {
        const float* cre = p.in[I_CRE] + (size_t)(lg * 16 + tt) * 64; const float* cim = p.in[I_CIM] + (size_t)(lg * 16 + tt) * 64;
#pragma unroll
        for (int s = 0; s < 16; ++s) { Cm[s] = cre[4 * s + cq]; Cm[16 + s] = -cim[4 * s + cq]; }
#pragma unroll
        for (int i = 0; i < 4; ++i) dsk[i] = p.in[I_S5D][l * 384 + g * 16 + cq * 4 + i];
    }
    int row0, ntok; float hr = 0.f, hi = 0.f;
    if (CARRY == 2) { row0 = MP + seq; ntok = 1; hr = p.in[I_S5RE][((size_t)(l * NS + seq) * 24 + g) * 64 + n]; hi = p.in[I_S5IM][((size_t)(l * NS + seq) * 24 + g) * 64 + n]; }
    else { row0 = seq * LP + j * LC; ntok = LC; }
    if (CARRY == 1) {
        float Lr = 1.f, Li = 0.f;
        for (int i = 0; i < LC; ++i) { const float a = Lr * abr - Li * abi, b = Lr * abi + Li * abr; Lr = a; Li = b; }
        const float* cs0 = CS + (size_t)((seq * 24 + g) * NC) * 128 + n;
        for (int i0 = 0; i0 < j; i0 += 8) { float er[8], ei[8];
#pragma unroll
            for (int u = 0; u < 8; ++u) { const int ii = min(i0 + u, j - 1); er[u] = cs0[(size_t)ii * 128]; ei[u] = cs0[(size_t)ii * 128 + 64]; }
#pragma unroll
            for (int u = 0; u < 8; ++u) { const bool ok = (i0 + u) < j; const float mr = ok ? Lr : 1.f, mi = ok ? Li : 0.f, ar = ok ? er[u] : 0.f, ai = ok ? ei[u] : 0.f;
                const float a = hr * mr - hi * mi + ar, b = hr * mi + hi * mr + ai; hr = a; hi = b; } }
    }
    for (int tb = 0; tb < ntok; tb += 16) {
        const int ti = min(tb + tt, ntok - 1); const size_t row = (size_t)(row0 + ti);
        const h4 uh = *(const h4*)(PROJ + row * DIN + g * 16 + cq * 4);
        float uf[4]; const int2 uhw = __builtin_bit_cast(int2, uh);
#pragma unroll
        for (int i = 0; i < 4; ++i) uf[i] = (float)uh[i];
#pragma unroll
        for (int t2 = 0; t2 < 16; ++t2) {
            if (tb + t2 < ntok) {
                float xr = 0.f, xi = 0.f;
#pragma unroll
                for (int c2 = 0; c2 < 8; ++c2) { const fp2_t up = __builtin_bit_cast(fp2_t, __builtin_amdgcn_readlane((c2 & 1) ? uhw.y : uhw.x, (c2 >> 1) * 16 + t2));
                    xr = __builtin_amdgcn_fdot2(Bpr[c2], up, xr, false); xi = __builtin_amdgcn_fdot2(Bpi[c2], up, xi, false); }
                const float a = abr * hr - abi * hi + xr, b = abr * hi + abi * hr + xi; hr = a; hi = b;
            }
            if (OUT) { ldsH[n * 17 + t2] = hr; ldsH[(64 + n) * 17 + t2] = hi; }
        }
        if (OUT) {
            __builtin_amdgcn_fence(__ATOMIC_RELEASE, "wavefront"); __builtin_amdgcn_wave_barrier(); __builtin_amdgcn_fence(__ATOMIC_ACQUIRE, "wavefront");
            f32x4 acc = (f32x4){0.f, 0.f, 0.f, 0.f};
#pragma unroll
            for (int s = 0; s < 32; ++s) acc = __builtin_amdgcn_mfma_f32_16x16x4f32(Cm[s], ldsH[(4 * s + cq) * 17 + tt], acc, 0, 0, 0);
            float z[4];
#pragma unroll
            for (int i = 0; i < 4; ++i) z[i] = gelu_t(acc[i] + dsk[i] * uf[i]);
            if (tb + tt < ntok) { uint2 w; w.x = cvt_pk_bf16(z[0], z[1]); w.y = cvt_pk_bf16(z[2], z[3]); *(uint2*)(Z + row * 384 + g * 16 + cq * 4) = w; }
            __builtin_amdgcn_fence(__ATOMIC_RELEASE, "wavefront"); __builtin_amdgcn_wave_barrier(); __builtin_amdgcn_fence(__ATOMIC_ACQUIRE, "wavefront");
        }
    }
    if (CARRY == 0) { float* o = CS + (size_t)((seq * 24 + g) * NC + j) * 128 + n; o[0] = hr; o[64] = hi; }
    if (CARRY == 1 && j == NC - 1) { p.out[O_PS5RE + ((size_t)(l * NB + seq) * 24 + g) * 64 + n] = hr; p.out[O_PS5IM + ((size_t)(l * NB + seq) * 24 + g) * 64 + n] = hi; }
    if (CARRY == 2) { p.out[O_SS5RE + ((size_t)(l * NS + seq) * 24 + g) * 64 + n] = hr; p.out[O_SS5IM + ((size_t)(l * NS + seq) * 24 + g) * 64 + n] = hi; }
}

DEVI float rw_prev(const Params& p, int l, const half_t* PROJ, int row, int jcol) {
    if (row >= MP) return p.in[I_SHIFT][(size_t)(l * NS + (row - MP)) * RPROJ + jcol];
    const int t = row % LP; return t == 0 ? 0.f : (float)PROJ[(size_t)(row - 1) * DIN + 384 + jcol];
}


DEVI void rw_prev4(const Params& p, int l, const half_t* PROJ, int row, int jcol, float (&o)[4]) {
    if (row >= MP) { const float4 v = *(const float4*)(p.in[I_SHIFT] + (size_t)(l * NS + (row - MP)) * RPROJ + jcol); o[0] = v.x; o[1] = v.y; o[2] = v.z; o[3] = v.w; return; }
    const int t = row % LP;
    if (t == 0) { o[0] = o[1] = o[2] = o[3] = 0.f; return; }
    const h4 v = *(const h4*)(PROJ + (size_t)(row - 1) * DIN + 384 + jcol); o[0] = (float)v[0]; o[1] = (float)v[1]; o[2] = (float)v[2]; o[3] = (float)v[3];
}
DEVI void phase_m1a(const Params& p, int l, float* lds) { LAUNDER_IDS;
    const half_t* PROJ = (const half_t*)(p.ws + OFF_PROJ); bf16_t* AX = (bf16_t*)(p.ws + OFF_AX); bf16_t* XC = (bf16_t*)(p.ws + OFF_XC);
    const float* mu = p.in[I_MU] + l * RPROJ; const float* cw = p.in[I_CW] + l * 4 * 256; const float* cb = p.in[I_CB] + l * 256;
    const int wid = TIDX >> 6, lane = TIDX & 63, c4 = lane * 4;
    float4 mu4, cb4, cw4[4];
    mu4 = *(const float4*)(mu + 1152 + c4); cb4 = *(const float4*)(cb + c4);
#pragma unroll
    for (int j = 0; j < 4; ++j) cw4[j] = *(const float4*)(cw + j * 256 + c4);
    const float muv[4] = {mu4.x, mu4.y, mu4.z, mu4.w}, cbv[4] = {cb4.x, cb4.y, cb4.z, cb4.w};
    for (int row = BIDX * 8 + wid; row < M; row += gridDim.x * 8) {
        const bool samp = row >= MP; const int b = row / LP, t = row - b * LP, sq = row - MP;
        const half_t* pr = PROJ + (size_t)row * DIN;
        { const h4 pv = *(const h4*)(pr + 384 + 1152 + c4); float pp[4]; rw_prev4(p, l, PROJ, row, 1152 + c4, pp); float o[4];
#pragma unroll
          for (int i = 0; i < 4; ++i) { const float x = (float)pv[i]; const float xm = x + (pp[i] - x) * muv[i]; o[i] = c4 < 64 ? tanh_f(xm) : (c4 < 128 ? xm : sigm(xm)); }
          uint2 w; w.x = cvt_pk_bf16(o[0], o[1]); w.y = cvt_pk_bf16(o[2], o[3]); *(uint2*)(AX + (size_t)row * 256 + c4) = w; }
        const h4 x0h = *(const h4*)(pr + 1792 + c4); float x0[4], xm1[4], xm2[4], xm3[4];
#pragma unroll
        for (int i = 0; i < 4; ++i) x0[i] = (float)x0h[i];
        if (samp) { const float* c0 = p.in[I_CONV] + (size_t)(l * NS + sq) * 3 * 256 + c4; const float4 a3 = *(const float4*)c0, a2 = *(const float4*)(c0 + 256), a1 = *(const float4*)(c0 + 512);
            xm3[0] = a3.x; xm3[1] = a3.y; xm3[2] = a3.z; xm3[3] = a3.w; xm2[0] = a2.x; xm2[1] = a2.y; xm2[2] = a2.z; xm2[3] = a2.w; xm1[0] = a1.x; xm1[1] = a1.y; xm1[2] = a1.z; xm1[3] = a1.w; }
        else { h4 h1 = (h4){0, 0, 0, 0}, h2 = h1, h3 = h1;
            if (t >= 1) h1 = *(const h4*)(pr + 1792 + c4 - DIN); if (t >= 2) h2 = *(const h4*)(pr + 1792 + c4 - 2 * DIN); if (t >= 3) h3 = *(const h4*)(pr + 1792 + c4 - 3 * DIN);
#pragma unroll
            for (int i = 0; i < 4; ++i) { xm1[i] = (float)h1[i]; xm2[i] = (float)h2[i]; xm3[i] = (float)h3[i]; } }
        { const float w0v[4] = {cw4[0].x, cw4[0].y, cw4[0].z, cw4[0].w}, w1v[4] = {cw4[1].x, cw4[1].y, cw4[1].z, cw4[1].w}, w2v[4] = {cw4[2].x, cw4[2].y, cw4[2].z, cw4[2].w}, w3v[4] = {cw4[3].x, cw4[3].y, cw4[3].z, cw4[3].w};
          float o[4];
#pragma unroll
          for (int i = 0; i < 4; ++i) o[i] = cbv[i] + w0v[i] * xm3[i] + w1v[i] * xm2[i] + w2v[i] * xm1[i] + w3v[i] * x0[i];
          uint2 w; w.x = cvt_pk_bf16(o[0], o[1]); w.y = cvt_pk_bf16(o[2], o[3]); *(uint2*)(XC + (size_t)row * 256 + c4) = w; }
        if (samp) {
            float* so = p.out + O_SSHIFT + (size_t)(l * NS + sq) * RPROJ;
            for (int j = c4; j < RPROJ; j += 256) { const h4 v = *(const h4*)(pr + 384 + j); *(float4*)(so + j) = make_float4((float)v[0], (float)v[1], (float)v[2], (float)v[3]); }
            float* co = p.out + O_SCONV + (size_t)(l * NS + sq) * 3 * 256 + c4;
            *(float4*)co = make_float4(xm2[0], xm2[1], xm2[2], xm2[3]); *(float4*)(co + 256) = make_float4(xm1[0], xm1[1], xm1[2], xm1[3]); *(float4*)(co + 512) = make_float4(x0[0], x0[1], x0[2], x0[3]);
        } else if (t >= LP - 3) {
            *(float4*)(p.out + O_PCONV + ((size_t)(l * NB + b) * 3 + (t - (LP - 3))) * 256 + c4) = make_float4(x0[0], x0[1], x0[2], x0[3]);
            if (t == LP - 1) { float* so = p.out + O_PSHIFT + (size_t)(l * NB + b) * RPROJ;
                for (int j = c4; j < RPROJ; j += 256) { const h4 v = *(const h4*)(pr + 384 + j); *(float4*)(so + j) = make_float4((float)v[0], (float)v[1], (float)v[2], (float)v[3]); } }
        }
    }
    for (int it = BIDX * 8 + wid; it < NB * 24 * NC; it += gridDim.x * 8) { const int j = it % NC, sg = it / NC; s5_item<0>(p, l, sg % 24, sg / 24, j, lds, lane); }
}

DEVI void phase_m1c(const Params& p, int l) { LAUNDER_IDS;
    const half_t* PROJ = (const half_t*)(p.ws + OFF_PROJ); const half_t* AA = (const half_t*)(p.ws + OFF_AA); half_t* RW = (half_t*)((unsigned char*)p.out + OOFF_RW);
    const float* mu = p.in[I_MU] + l * RPROJ; const int wid = TIDX >> 6, lane = TIDX & 63;
    struct RwIn { h4 pv, aa, wr0, prr; float pp[4], ppr[4]; float4 mu4, kk4, ka4, a04, w04, mur4; half_t* o; half_t* rl; };
    auto rw_load = [&](int it, RwIn& q) {
        const int pair = it * 4 + (lane >> 4), row = pair / RH, h = pair - row * RH, col = h * 64 + (lane & 15) * 4;
        q.pv = *(const h4*)(PROJ + (size_t)row * DIN + 768 + col); rw_prev4(p, l, PROJ, row, 384 + col, q.pp);
        q.aa = __builtin_nontemporal_load((const h4*)(AA + (size_t)row * 384 + col)); q.o = RW + (size_t)row * 1536 + col * 4; q.wr0 = *(const h4*)q.o;
        q.mu4 = *(const float4*)(mu + 384 + col); q.kk4 = *(const float4*)(p.in[I_KK] + l * 384 + col); q.ka4 = *(const float4*)(p.in[I_KA] + l * 384 + col);
        q.a04 = *(const float4*)(p.in[I_A0] + l * 384 + col); q.w04 = *(const float4*)(p.in[I_W0] + l * 384 + col);
        q.prr = *(const h4*)(PROJ + (size_t)row * DIN + 384 + col); rw_prev4(p, l, PROJ, row, col, q.ppr); q.mur4 = *(const float4*)(mu + col); q.rl = (half_t*)(p.ws + OFF_RL) + (size_t)row * 384 + col; };
    auto rw_finish = [&](const RwIn& q) {
        const float muv[4] = {q.mu4.x, q.mu4.y, q.mu4.z, q.mu4.w}, kkv[4] = {q.kk4.x, q.kk4.y, q.kk4.z, q.kk4.w}, kav[4] = {q.ka4.x, q.ka4.y, q.ka4.z, q.ka4.w},
                    a0v[4] = {q.a04.x, q.a04.y, q.a04.z, q.a04.w}, w0v[4] = {q.w04.x, q.w04.y, q.w04.z, q.w04.w};
        float kraw[4], a[4], kkr[4], ss = 0.f;
#pragma unroll
        for (int i = 0; i < 4; ++i) { const float x = (float)q.pv[i]; kraw[i] = x + (q.pp[i] - x) * muv[i]; a[i] = sigm(a0v[i] + (float)q.aa[i]); kkr[i] = kraw[i] * kkv[i]; ss = fmaf(kkr[i], kkr[i], ss); }
        ss = red16(ss); const float inv = 1.f / fmaxf(sqrtf(ss), 1e-12f);
        h4 oo, okp, okk, oka;
#pragma unroll
        for (int i = 0; i < 4; ++i) { const float e = sigm(w0v[i] + (float)q.wr0[i]) * 0.6065306597f; const float kk = kkr[i] * inv;
            oo[i] = (half_t)(1.f - __expf(-e)); okp[i] = (half_t)(kraw[i] * (1.f + (a[i] - 1.f) * kav[i])); okk[i] = (half_t)kk; oka[i] = (half_t)(kk * a[i]); }
        *(h4*)q.o = oo; *(h4*)(q.o + 4) = okk; { h8 pk; pk[0] = okp[0]; pk[1] = oka[0]; pk[2] = okp[1]; pk[3] = oka[1]; pk[4] = okp[2]; pk[5] = oka[2]; pk[6] = okp[3]; pk[7] = oka[3]; *(h8*)(q.o + 8) = pk; }
        { const float mr[4] = {q.mur4.x, q.mur4.y, q.mur4.z, q.mur4.w}; h4 orl;
#pragma unroll
          for (int i = 0; i < 4; ++i) { const float x = (float)q.prr[i]; orl[i] = (half_t)(x + (q.ppr[i] - x) * mr[i]); }
          *(h4*)q.rl = orl; } };
    { const int nit = M * RH / 4, st = gridDim.x * 8;
      for (int it = BIDX * 8 + wid; it < nit; it += 2 * st) {
          const bool has2 = it + st < nit; RwIn qa, qb; rw_load(it, qa); rw_load(has2 ? it + st : it, qb);
          rw_finish(qa); if (has2) rw_finish(qb); } }
    const half_t* LA = (const half_t*)(p.ws + OFF_LA); const half_t* GX = (const half_t*)(p.ws + OFF_GX); float* LCS = (float*)(p.ws + OFF_LCS);
    const float* cw = p.in[I_CW] + l * 4 * 256; const float* cb = p.in[I_CB] + l * 256;
    for (int id = BIDX * blockDim.x + TIDX; id < NB * NC * 256; id += gridDim.x * blockDim.x) {
        const int c = id & 255, bj = id >> 8, j = bj % NC, b = bj / NC, t0 = j * LC; const size_t row0 = (size_t)b * LP + t0;
        const half_t* px = PROJ + row0 * DIN + 1792 + c;
        float xm1 = t0 >= 1 ? (float)px[-DIN] : 0.f, xm2 = t0 >= 2 ? (float)px[-2 * DIN] : 0.f, xm3 = t0 >= 3 ? (float)px[-3 * DIN] : 0.f;
        const float w0 = cw[c], w1 = cw[256 + c], w2 = cw[512 + c], w3 = cw[768 + c], bb = cb[c];
        const float lmv = p.in[I_LAM][l * 256 + c], ls8 = logsig8(lmv), bav = p.in[I_BA][l * 256 + c], bxv = p.in[I_BX][l * 256 + c];
        float A = 1.f, hh = 0.f;
        for (int t8 = 0; t8 < LC; t8 += 8) { half_t xh[8], lh[8], gh[8];
#pragma unroll
            for (int u = 0; u < 8; ++u) { xh[u] = px[(size_t)(t8 + u) * DIN]; lh[u] = LA[(row0 + t8 + u) * 256 + c]; gh[u] = GX[(row0 + t8 + u) * 256 + c]; }
#pragma unroll
            for (int u = 0; u < 8; ++u) { const float x0 = (float)xh[u]; const float la = sigm((float)lh[u] + bav) * ls8, gx = sigm((float)gh[u] + bxv);
                const float xc = bb + w0 * xm3 + w1 * xm2 + w2 * xm1 + w3 * x0; const float a = __expf(la); const float bm = sqrtf(fmaxf(1.f - __expf(2.f * la), 0.f));
                hh = a * hh + bm * gx * xc; A *= a; xm3 = xm2; xm2 = xm1; xm1 = x0; } }
        LCS[(size_t)id * 2] = A; LCS[(size_t)id * 2 + 1] = hh;
    }
}
DEVI float rwkv_step(float (&S)[4], const h4 om, const h4 kk, const h8 kpka, const float (&r)[4], float v) {
    float sa = 0.f;
#pragma unroll
    for (int i = 0; i < 4; ++i) sa = fmaf(-S[i], (float)kk[i], sa);
    float tmp[4];
#pragma unroll
    for (int i = 0; i < 4; ++i) tmp[i] = fmaf(-(float)om[i], S[i], S[i]);
    sa = red16(sa);
    const fp2_t vs = __builtin_amdgcn_cvt_pkrtz(v, sa);
    const uint4 pk = __builtin_bit_cast(uint4, kpka);
    S[0] = __builtin_amdgcn_fdot2(__builtin_bit_cast(fp2_t, pk.x), vs, tmp[0], false); S[1] = __builtin_amdgcn_fdot2(__builtin_bit_cast(fp2_t, pk.y), vs, tmp[1], false);
    S[2] = __builtin_amdgcn_fdot2(__builtin_bit_cast(fp2_t, pk.z), vs, tmp[2], false); S[3] = __builtin_amdgcn_fdot2(__builtin_bit_cast(fp2_t, pk.w), vs, tmp[3], false);
    float y = 0.f;
#pragma unroll
    for (int i = 0; i < 4; ++i) y = fmaf(S[i], r[i], y);
    return red16(y);
}
typedef __attribute__((address_space(1))) const half_t g_half;
typedef __attribute__((address_space(1))) const h4 g_h4;
typedef __attribute__((address_space(1))) const h8 g_h8;
typedef __attribute__((address_space(1))) float g_float;
DEVI void rwkv_prompt(const Params& p, int l, int b, int h, int rg, int lane) {
    const int vrow = rg * 4 + (lane >> 4), kq = lane & 15;
    const g_half* RWp = (const g_half*)((const half_t*)((const unsigned char*)p.out + OOFF_RW) + (size_t)(b * LP) * 1536 + (h * 64 + kq * 4) * 4);
    const g_half* PRr = (const g_half*)((const half_t*)(p.ws + OFF_RL) + (size_t)(b * LP) * 384 + h * 64 + kq * 4);
    const g_half* PRv = (const g_half*)((const half_t*)(p.ws + OFF_PROJ) + (size_t)(b * LP) * DIN + 384 + 768 + h * 64 + vrow);
    g_float* yout = (g_float*)((float*)(p.ws + OFF_YR) + (size_t)(b * LP) * 384 + h * 64 + vrow);
    const float* mu = p.in[I_MU] + l * RPROJ;
    const float muv = mu[768 + h * 64 + vrow], omv = 1.f - muv;
    float S[4] = {0.f, 0.f, 0.f, 0.f}, pm_v = 0.f;
    constexpr int PD = 12;
    h4 om[PD], kk[PD], rr[PD]; h8 kpka[PD]; half_t vv[PD];
#define RW_LD(u, t) do { const g_half* a_ = RWp + (size_t)(t) * 1536; { const h8 q0_ = *(const g_h8*)a_; om[u] = __builtin_shufflevector(q0_, q0_, 0, 1, 2, 3); kk[u] = __builtin_shufflevector(q0_, q0_, 4, 5, 6, 7); kpka[u] = *(const g_h8*)(a_ + 8); } \
        rr[u] = *(const g_h4*)(PRr + (size_t)(t) * 384); vv[u] = PRv[(size_t)(t) * DIN]; } while (0)
#pragma unroll
    for (int u = 0; u < PD; ++u) RW_LD(u, u);
    for (int t = 0; t < LP; t += PD) {
#pragma unroll
        for (int u = 0; u < PD; ++u) {
            float r[4];
#pragma unroll
            for (int i = 0; i < 4; ++i) r[i] = (float)rr[u][i];
            const float v = fmaf((float)vv[u], omv, pm_v); pm_v = (float)vv[u] * muv;
            const float y = rwkv_step(S, om[u], kk[u], kpka[u], r, v);
            yout[(size_t)(t + u) * 384] = y;
            RW_LD(u, t + PD + u);
        }
    }
#undef RW_LD
    *(float4*)(p.out + O_PRWKV + ((size_t)((l * NB + b) * RH + h) * 64 + vrow) * 64 + kq * 4) = make_float4(S[0], S[1], S[2], S[3]);
}
DEVI void rwkv_sample(const Params& p, int l, int s, int h, int rg, int lane) {
    const int vrow = rg * 4 + (lane >> 4), kq = lane & 15; const size_t row = (size_t)(MP + s);
    const half_t* RWp = (const half_t*)((const unsigned char*)p.out + OOFF_RW) + row * 1536 + (h * 64 + kq * 4) * 4;
    const half_t* PR = (const half_t*)(p.ws + OFF_PROJ) + row * DIN + 384;
    const float* mu = p.in[I_MU] + l * RPROJ; const float* sh = p.in[I_SHIFT] + (size_t)(l * NS + s) * RPROJ;
    const size_t so = ((size_t)((l * NS + s) * RH + h) * 64 + vrow) * 64 + kq * 4;
    const float4 s4 = *(const float4*)(p.in[I_RWKV] + so); float S[4] = {s4.x, s4.y, s4.z, s4.w};
    const h4 c_r = *(const h4*)((const half_t*)(p.ws + OFF_RL) + row * 384 + h * 64 + kq * 4); float r[4];
#pragma unroll
    for (int i = 0; i < 4; ++i) r[i] = (float)c_r[i];
    const float xv = (float)PR[768 + h * 64 + vrow]; const float v = xv + (sh[768 + h * 64 + vrow] - xv) * mu[768 + h * 64 + vrow];
    const float y = rwkv_step(S, *(const h4*)RWp, *(const h4*)(RWp + 4), *(const h8*)(RWp + 8), r, v);
    if (kq == 0) ((float*)(p.ws + OFF_YR))[row * 384 + h * 64 + vrow] = y;
    *(float4*)(p.out + O_SRWKV + so) = make_float4(S[0], S[1], S[2], S[3]);
}
DEVI void lru_item(const Params& p, int l, bool samp, int seq, int j, int c) {
    const half_t* PROJ = (const half_t*)(p.ws + OFF_PROJ); const half_t* LA = (const half_t*)(p.ws + OFF_LA); const half_t* GX = (const half_t*)(p.ws + OFF_GX);
    const float* LCS = (const float*)(p.ws + OFF_LCS); bf16_t* MIX = (bf16_t*)(p.ws + OFF_MIX);
    const float* cw = p.in[I_CW] + l * 4 * 256; const float w0 = cw[c], w1 = cw[256 + c], w2 = cw[512 + c], w3 = cw[768 + c], bb = p.in[I_CB][l * 256 + c];
    const float lmv = p.in[I_LAM][l * 256 + c], ls8 = logsig8(lmv), bav = p.in[I_BA][l * 256 + c], bxv = p.in[I_BX][l * 256 + c];
    float hh = 0.f, xm1, xm2, xm3; size_t row0; int ntok;
    if (samp) { row0 = (size_t)(MP + seq); ntok = 1; hh = p.in[I_LRU][(size_t)(l * NS + seq) * 256 + c];
        const float* c0 = p.in[I_CONV] + (size_t)(l * NS + seq) * 3 * 256 + c; xm3 = c0[0]; xm2 = c0[256]; xm1 = c0[512]; }
    else { const int t0 = j * LC; row0 = (size_t)seq * LP + t0; ntok = LC; const half_t* px = PROJ + row0 * DIN + 1792 + c;
        xm1 = t0 >= 1 ? (float)px[-DIN] : 0.f; xm2 = t0 >= 2 ? (float)px[-2 * DIN] : 0.f; xm3 = t0 >= 3 ? (float)px[-3 * DIN] : 0.f;
        const float* cs = LCS + ((size_t)(seq * NC) * 256 + c) * 2;
        for (int i0 = 0; i0 < j; i0 += 8) { float2 e[8];
#pragma unroll
            for (int u = 0; u < 8; ++u) { const int ii = min(i0 + u, j - 1); e[u] = *(const float2*)(cs + (size_t)ii * 512); }
#pragma unroll
            for (int u = 0; u < 8; ++u) { const bool ok = (i0 + u) < j; hh = ok ? fmaf(hh, e[u].x, e[u].y) : hh; } }
    }
    for (int t8 = 0; t8 < ntok; t8 += 8) { half_t xh[8], glh[8], lh[8], gh[8];
#pragma unroll
        for (int u = 0; u < 8; ++u) { const size_t row = row0 + min(t8 + u, ntok - 1); const half_t* pr = PROJ + row * DIN; xh[u] = pr[1792 + c]; glh[u] = pr[2048 + c]; lh[u] = LA[row * 256 + c]; gh[u] = GX[row * 256 + c]; }
#pragma unroll
        for (int u = 0; u < 8; ++u) if (t8 + u < ntok) { const size_t row = row0 + t8 + u;
            const float x0 = (float)xh[u], gl = (float)glh[u], la = sigm((float)lh[u] + bav) * ls8, gx = sigm((float)gh[u] + bxv);
            const float xc = bb + w0 * xm3 + w1 * xm2 + w2 * xm1 + w3 * x0; const float a = __expf(la); const float bm = sqrtf(fmaxf(1.f - __expf(2.f * la), 0.f));
            hh = a * hh + bm * gx * xc; xm3 = xm2; xm2 = xm1; xm1 = x0;
            MIX[row * DM + 768 + c] = f2bf(hh * gelu_t(gl)); } }
    if (samp) p.out[O_SLRU + (size_t)(l * NS + seq) * 256 + c] = hh;
    else if (j == NC - 1) p.out[O_PLRU + (size_t)(l * NB + seq) * 256 + c] = hh;
}
constexpr int N_S5P = NB * 24 * NC, N_S5S = NS * 24, N_LRP = NB * NC * 4, N_LRS = NS * 4, N_RWS = NS * RH * 16;
DEVI void phase_m2(const Params& p, int l, float* lds) { LAUNDER_IDS;
    const int wid = TIDX >> 6, lane = TIDX & 63;
    const int swi = wid == 0 ? 0 : (wid == 2 ? 1 : (wid == 5 ? 2 : -1)), wki = wid == 1 ? 0 : (wid == 3 ? 1 : (wid == 4 ? 2 : (wid == 6 ? 3 : 4)));
    if (swi >= 0) {
        __builtin_amdgcn_s_setprio(3);
        const int xcd = BIDX & 7, slot = BIDX >> 3;
        for (int q = slot * 3 + swi; q < 96; q += (gridDim.x >> 3) * 3) rwkv_prompt(p, l, xcd, q >> 4, q & 15, lane);
        __builtin_amdgcn_s_setprio(0);
    } else {
        float* ldsH = lds + wki * (128 * 17);
        const int nwk = gridDim.x * 5;
        for (int it = BIDX * 5 + wki; it < N_S5P + N_S5S + N_LRP + N_LRS + N_RWS; it += nwk) {
            int k = it;
            if (k < N_S5P) { const int j = k % NC, sg = k / NC; s5_item<1>(p, l, sg % 24, sg / 24, j, ldsH, lane); continue; }
            k -= N_S5P;
            if (k < N_S5S) { s5_item<2>(p, l, k % 24, k / 24, 0, ldsH, lane); continue; }
            k -= N_S5S;
            if (k < N_LRP) { const int cq = k & 3, bj = k >> 2; lru_item(p, l, false, bj / NC, bj % NC, cq * 64 + lane); continue; }
            k -= N_LRP;
            if (k < N_LRS) { lru_item(p, l, true, k >> 2, 0, (k & 3) * 64 + lane); continue; }
            k -= N_LRS;
            { const int rg = k & 15, sh = k >> 4; rwkv_sample(p, l, sh / RH, sh % RH, rg, lane); }
        }
    }
}
DEVI void phase_m3_fin(const Params& p, int l) { LAUNDER_IDS;
    const half_t* PROJ = (const half_t*)(p.ws + OFF_PROJ); const half_t* RW = (const half_t*)((const unsigned char*)p.out + OOFF_RW); const half_t* GG = (const half_t*)(p.ws + OFF_GG);
    const float* YR = (const float*)(p.ws + OFF_YR); bf16_t* MIX = (bf16_t*)(p.ws + OFF_MIX); const float* mu = p.in[I_MU] + l * RPROJ;
    const int wid = TIDX >> 6, lane = TIDX & 63;
    const bf16_t* Zb = (const bf16_t*)((const unsigned char*)p.out + OOFF_Z); const half_t* GLR = (const half_t*)(p.ws + OFF_GLR);
    struct FinIn { float4 y4, mur4, muv4, rk4, lw4, lb4, gb4; h4 prh, pvh, kph, ggh, glh; uint2 zz; float ppr[4], ppv[4]; int row, col; };
    auto fin_load = [&](int it, FinIn& q) {
        const int pair = it * 4 + (lane >> 4), row = pair / RH, h = pair - row * RH, col = h * 64 + (lane & 15) * 4; q.row = row; q.col = col;
        { const f32x4 t_ = __builtin_nontemporal_load((const f32x4*)(YR + (size_t)row * 384 + col)); q.y4 = make_float4(t_[0], t_[1], t_[2], t_[3]); }
        q.prh = *(const h4*)((const half_t*)(p.ws + OFF_RL) + (size_t)row * 384 + col); q.pvh = *(const h4*)(PROJ + (size_t)row * DIN + 384 + 768 + col); { const h8 pk = *(const h8*)(RW + (size_t)row * 1536 + col * 4 + 8); q.kph = __builtin_shufflevector(pk, pk, 0, 2, 4, 6); }
        q.ggh = __builtin_nontemporal_load((const h4*)(GG + (size_t)row * 384 + col)); q.glh = __builtin_nontemporal_load((const h4*)(GLR + (size_t)row * 384 + col)); q.zz = *(const uint2*)(Zb + (size_t)row * 384 + col);
        rw_prev4(p, l, PROJ, row, 768 + col, q.ppv);
        q.mur4 = *(const float4*)(mu + col); q.muv4 = *(const float4*)(mu + 768 + col); q.rk4 = *(const float4*)(p.in[I_RK] + l * 384 + col); q.lw4 = *(const float4*)(p.in[I_LNW] + l * 384 + col);
        q.lb4 = *(const float4*)(p.in[I_LNB] + l * 384 + col); q.gb4 = *(const float4*)(p.in[I_GLUB] + l * 384 + col); };
    auto fin_finish = [&](const FinIn& q) {
        const float y[4] = {q.y4.x, q.y4.y, q.y4.z, q.y4.w}, mur[4] = {q.mur4.x, q.mur4.y, q.mur4.z, q.mur4.w}, muv[4] = {q.muv4.x, q.muv4.y, q.muv4.z, q.muv4.w}, rk[4] = {q.rk4.x, q.rk4.y, q.rk4.z, q.rk4.w},
                    lw[4] = {q.lw4.x, q.lw4.y, q.lw4.z, q.lw4.w}, lb[4] = {q.lb4.x, q.lb4.y, q.lb4.z, q.lb4.w}, gb[4] = {q.gb4.x, q.gb4.y, q.gb4.z, q.gb4.w};
        const float zf[4] = {__uint_as_float(q.zz.x << 16), __uint_as_float(q.zz.x & 0xffff0000u), __uint_as_float(q.zz.y << 16), __uint_as_float(q.zz.y & 0xffff0000u)};
        const float mean = red16(y[0] + y[1] + y[2] + y[3]) * (1.f / 64.f);
        float d[4], vs = 0.f, bs = 0.f, v[4];
#pragma unroll
        for (int i = 0; i < 4; ++i) { d[i] = y[i] - mean; vs = fmaf(d[i], d[i], vs); const float r = (float)q.prh[i]; const float xv = (float)q.pvh[i]; v[i] = xv + (q.ppv[i] - xv) * muv[i];
            bs = fmaf(r * (float)q.kph[i], rk[i], bs); }
        const float rstd = rsqrtf(red16(vs) * (1.f / 64.f) + 64e-5f); bs = red16(bs);
        float o[4], og[4];
#pragma unroll
        for (int i = 0; i < 4; ++i) { o[i] = (d[i] * rstd * lw[i] + lb[i] + bs * v[i]) * (float)q.ggh[i]; og[i] = zf[i] * sigm((float)q.glh[i] + gb[i]); }
        uint2 w; w.x = cvt_pk_bf16(o[0], o[1]); w.y = cvt_pk_bf16(o[2], o[3]); *(uint2*)(MIX + (size_t)q.row * DM + 384 + q.col) = w;
        w.x = cvt_pk_bf16(og[0], og[1]); w.y = cvt_pk_bf16(og[2], og[3]); *(uint2*)(MIX + (size_t)q.row * DM + q.col) = w; };
    { const int nit = M * RH / 4, st = gridDim.x * 8;
      for (int it = BIDX * 8 + wid; it < nit; it += 2 * st) {
          const bool has2 = it + st < nit; FinIn qa, qb; fin_load(it, qa); fin_load(has2 ? it + st : it, qb);
          fin_finish(qa); if (has2) fin_finish(qb); } }
}

#define XB_TMO      128
#define XB_XCNT(j)  (256  + 64 * (j))
#define XB_XSUB(j)  (1280 + 64 * (j))
#define XB_XGEN(j)  (2304 + 64 * (j))
#define XB_TOP      3328
#define XB_TOPGEN   3392
#define XCD_BAR_WORDS 3456
#define XB_SPIN_CAP (1u << 18)
#define XLAS __attribute__((address_space(3)))

__device__ __forceinline__ unsigned xb_ld(unsigned* p)              { return __hip_atomic_load(p, __ATOMIC_RELAXED, __HIP_MEMORY_SCOPE_AGENT); }
__device__ __forceinline__ unsigned xb_add(unsigned* p, unsigned v) { return __hip_atomic_fetch_add(p, v, __ATOMIC_RELAXED, __HIP_MEMORY_SCOPE_AGENT); }
__device__ __forceinline__ unsigned xb_xcc_id() { return (unsigned)__builtin_amdgcn_s_getreg((3 << 11) | 20) & 0xFu; }
#define XB_SPIN(cond, bar) do { unsigned _sp = 0; while (cond) { __builtin_amdgcn_s_sleep(1); \
    if ((++_sp & 255u) == 0u) { if (xb_ld(&(bar)[XB_TMO])) break; if (_sp > XB_SPIN_CAP) { atomicAdd(&(bar)[XB_TMO], 1u); break; } } } } while (0)

struct XcdBarrier {
    unsigned* bar; unsigned x;
    volatile XLAS unsigned* st;
};

__device__ __forceinline__ XcdBarrier xcd_barrier_post(unsigned* bar, volatile XLAS unsigned* st) {
    XcdBarrier b; b.bar = bar; b.x = xb_xcc_id(); b.st = st;
    if (threadIdx.x == 0) (void)xb_add(&bar[XB_XCNT(b.x)], 1u);
    return b;
}
__device__ __forceinline__ void xcd_barrier_complete(unsigned* bar, unsigned x, unsigned& nloc, unsigned& nx) {
    const unsigned G = gridDim.x * gridDim.y * gridDim.z;
    unsigned sum, cnt, mine, sp = 0u;
    for (;;) {
        sum = 0u; cnt = 0u; mine = 0u;
#pragma unroll
        for (unsigned j = 0; j < 16; ++j) { const unsigned c = xb_ld(&bar[XB_XCNT(j)]); sum += c; cnt += (c > 0u) ? 1u : 0u; mine = (j == x) ? c : mine; }
        if (sum == G) break;
        __builtin_amdgcn_s_sleep(1);
        if ((++sp & 255u) == 0u) { if (xb_ld(&bar[XB_TMO])) break; if (sp > XB_SPIN_CAP) { atomicAdd(&bar[XB_TMO], 1u); break; } }
    }
    nloc = mine > 0u ? mine : 1u; nx = cnt > 0u ? cnt : 1u;
}

__device__ __forceinline__ void xcd_barrier(const XcdBarrier& b) {
    asm volatile("s_waitcnt vmcnt(0)" ::: "memory");
    __syncthreads();
    if (threadIdx.x == 0) {
        unsigned* bar = b.bar;
        __builtin_amdgcn_s_waitcnt(0);
        unsigned nloc = b.st[0], nx = b.st[1];
        if (nloc == 0u) { xcd_barrier_complete(bar, b.x, nloc, nx); b.st[0] = nloc; b.st[1] = nx; }
        const unsigned old = xb_add(&bar[XB_XSUB(b.x)], 1u);
        const unsigned gen = old / nloc;
        if (old + 1u == (gen + 1u) * nloc) {
            __builtin_amdgcn_fence(__ATOMIC_RELEASE, "agent");
            asm volatile("s_waitcnt vmcnt(0)" ::: "memory");
            const unsigned og = xb_add(&bar[XB_TOP], 1u);
            const unsigned tg = og / nx;
            if (og + 1u == (tg + 1u) * nx) xb_add(&bar[XB_TOPGEN], 1u);
            else XB_SPIN(xb_ld(&bar[XB_TOPGEN]) == tg, bar);
            __builtin_amdgcn_fence(__ATOMIC_ACQUIRE, "agent");
            xb_add(&bar[XB_XGEN(b.x)], 1u);
            asm volatile("s_waitcnt vmcnt(0)" ::: "memory");
        } else {
            XB_SPIN(xb_ld(&bar[XB_XGEN(b.x)]) == gen, bar);
            __builtin_amdgcn_fence(__ATOMIC_ACQUIRE, "agent");
            asm volatile("s_waitcnt vmcnt(0)" ::: "memory");
        }
    }
    __syncthreads();
}

constexpr int PH_PER_LAYER = 15, N_PHASES = 1 + 2 * PH_PER_LAYER;
__global__ void __launch_bounds__(512, 2) mega(Params p_arg, int ph_begin, int ph_end) {
    extern __shared__ __attribute__((aligned(16))) unsigned char shm[];
    PG8_LAS unsigned char* lds = (PG8_LAS unsigned char*)shm; float* ldsf = (float*)shm;
    __shared__ uint4 xb_words;
    if (threadIdx.x == 0) xb_words = make_uint4(0u, 0u, 0u, 0u);
    __syncthreads();
    XcdBarrier xb;
    { const Params* pq0 = (const Params*)__builtin_amdgcn_kernarg_segment_ptr(); xb = xcd_barrier_post((unsigned*)(pq0->ws + OFF_BAR), (volatile XLAS unsigned*)&xb_words); }
    if (ph_begin < 0) cg::this_grid().sync();
    for (int ph = ph_begin; ph < ph_end; ++ph) {
        if (ph > ph_begin) xcd_barrier(xb);
        const Params* pq = (const Params*)__builtin_amdgcn_kernarg_segment_ptr(); asm volatile("" : "+s"(pq)); const Params& p = *pq;
        bf16_t* WGU = (bf16_t*)(p.ws + OFF_WGU); bf16_t* WD = (bf16_t*)(p.ws + OFF_WD); bf16_t* XN = (bf16_t*)(p.ws + OFF_XN); bf16_t* ACT = (bf16_t*)(p.ws + OFF_ACT);
        float* H = (float*)(p.ws + OFF_H);
        if (ph == 0) { conv_ffn(p, 0, 0, ldsf); conv_mix(p, 0, ldsf); norm_phase<0>(p, p.in[I_F1N]); continue; }
        const int l = (ph - 1) / PH_PER_LAYER, s = (ph - 1) % PH_PER_LAYER;
        int ngemm = 0; const bf16_t* gA = nullptr; const bf16_t* gB = nullptr; int gN = 0, gK = 0; EpiAll E; E.mode = 0;
        E.sw.act = ACT; E.rs.H = H; E.rs.scale = 0.5f; E.rs.row_base = 0; E.rs.pm_mul = 1; E.rs.atomic = 0; int gM = M, resid = 0; E.f16.O0 = nullptr; E.f16.O1 = nullptr; E.f16.O2 = nullptr; E.f16.ld0 = 0; E.f16.ld12 = 0; E.f16.ncols = 0; E.f16.segw = 0; E.f16.cs0 = 1;
        switch (s) {
        case 0: case 12: ngemm = 1; gA = XN; gB = WGU; gN = 2 * DFF; gK = DM; E.mode = 0; break;
        case 1: case 13: ngemm = 2; gM = 16384; gA = ACT; gB = WD; gN = DM; gK = DFF; E.mode = 2; resid = 1; E.f16.O0 = (half_t*)(p.ws + OFF_XN); E.f16.ld0 = DM; E.f16.ncols = DM; break;
        case 10: ngemm = 2; gM = 16384; gA = (const bf16_t*)(p.ws + OFF_MIX); gB = (const bf16_t*)(p.ws + OFF_WOUT); gN = DM; gK = DM; E.mode = 2; resid = 1; E.rs.scale = 1.0f; E.f16.O0 = (half_t*)(p.ws + OFF_PROJ); E.f16.ld0 = DM; E.f16.ncols = DM; break;
        case 2: norm_phase<1>(p, p.in[I_MIXN] + l * DM, DFF / 256, (const half_t*)(p.ws + OFF_XN), 0.5f); break;
        case 3: ngemm = 1; gA = XN; gB = (const bf16_t*)(p.ws + OFF_WIN); gN = DIN; gK = DM; E.mode = 2; E.f16.O0 = (half_t*)(p.ws + OFF_PROJ); E.f16.ld0 = DIN; E.f16.ncols = DIN; break;
        case 4: phase_m1a(p, l, ldsf); break;
        case 5: ngemm = 2; gA = (const bf16_t*)(p.ws + OFF_AX); gB = (const bf16_t*)(p.ws + OFF_WLR); gN = 1280; gK = 256; E.mode = 2;
            E.f16.O0 = (half_t*)((unsigned char*)p.out + OOFF_RW); E.f16.O1 = (half_t*)(p.ws + OFF_AA); E.f16.O2 = (half_t*)(p.ws + OFF_GG); E.f16.ld0 = 1536; E.f16.ld12 = 384; E.f16.ncols = 1152; E.f16.segw = 384; E.f16.cs0 = 4; break;
        case 6: phase_m1c(p, l); break;
        case 7: phase_m2(p, l, ldsf); break;
        case 8: ngemm = 1; gA = (const bf16_t*)((const unsigned char*)p.out + OOFF_Z); gB = (const bf16_t*)(p.ws + OFF_WGLU); gN = 512; gK = 384; E.mode = 2;
            E.f16.O0 = (half_t*)(p.ws + OFF_GLR); E.f16.ld0 = 384; E.f16.ncols = 384; break;
        case 9: phase_m3_fin(p, l); break;
        case 11: conv_ffn(p, l, 1, ldsf); norm_phase<1>(p, p.in[I_F2N] + l * DM, DM / 256, (const half_t*)(p.ws + OFF_PROJ), 1.0f); break;
        case 14: if (l == 1) norm_phase<2>(p, p.in[I_FINN], DFF / 256, (const half_t*)(p.ws + OFF_XN), 0.5f); else { conv_ffn(p, l + 1, 0, ldsf); conv_mix(p, l + 1, ldsf); norm_phase<1>(p, p.in[I_F1N] + (l + 1) * DM, DFF / 256, (const half_t*)(p.ws + OFF_XN), 0.5f); } break;
        }
        int gld = gK; size_t ga_pm = (size_t)256 * gK * 2, gb_pm = 0;
        for (int gi = 0; gi < ngemm; ++gi) {
            if (gi == 1 && !resid) {
                gA = (const bf16_t*)(p.ws + OFF_XC); gB = (const bf16_t*)(p.ws + OFF_WLRU); gN = 512; gK = 256; gld = 256; ga_pm = (size_t)256 * 256 * 2;
                E.f16.O0 = (half_t*)(p.ws + OFF_LA); E.f16.O1 = (half_t*)(p.ws + OFF_GX); E.f16.O2 = E.f16.O1; E.f16.ld0 = 256; E.f16.ld12 = 256; E.f16.ncols = 512; E.f16.segw = 256; E.f16.cs0 = 1; }
            if (gi == 1 && resid) { E.mode = 1;
                gA += (size_t)16384 * gK; gM = 256 * (gK / 256); ga_pm = 512; gb_pm = 512; gK = 256;
                E.rs.H = (float*)(p.ws + OFF_PART); E.rs.row_base = 0; E.rs.pm_mul = 1; E.rs.atomic = 1; }
            run_gemm(lds, gA, gB, gM, gN, gK, gld, ga_pm, gb_pm, E.mode != 1 ? 1 : 0, E);
        }
    }
}

extern "C" void kernel_launch(void* const* d_in, const int* in_sizes, int n_in, void* d_out, int out_size, void* d_ws, size_t ws_size, hipStream_t stream) {
    constexpr size_t kDynLds = pg8::STAGE_BYTES;
    static int grid_blocks = 0;
    if (!grid_blocks) {
        hipFuncSetAttribute((const void*)mega, hipFuncAttributeMaxDynamicSharedMemorySize, (int)kDynLds);
        int dev = 0, cus = 0, per_cu = 0; hipGetDevice(&dev); hipDeviceGetAttribute(&cus, hipDeviceAttributeMultiprocessorCount, dev);
        hipOccupancyMaxActiveBlocksPerMultiprocessor(&per_cu, mega, 512, kDynLds);
        if (per_cu < 1) per_cu = 1;
        grid_blocks = cus;
        if (grid_blocks % 8) grid_blocks -= grid_blocks % 8;
    }
    Params p{};
    for (int i = 0; i < N_IN; ++i) p.in[i] = (const float*)d_in[i];
    p.out = (float*)d_out; p.ws = (unsigned char*)d_ws;
#ifdef MULTI_LAUNCH
    for (int ph = 0; ph < N_PHASES; ++ph) hipLaunchKernelGGL(mega, dim3(grid_blocks), dim3(512), kDynLds, stream, p, ph, ph + 1);
#else
    hipMemsetAsync((unsigned char*)d_ws + OFF_BAR, 0, BAR_BYTES, stream);
    int b = 0, e = N_PHASES; void* args[] = {&p, &b, &e};
    hipError_t err = hipLaunchCooperativeKernel((void*)mega, dim3(grid_blocks), dim3(512), args, kDynLds, stream);
    if (err != hipSuccess) fprintf(stderr, "cooperative launch failed: %s (grid %d)\n", hipGetErrorString(err), grid_blocks);
#endif
}
```

```cpp
#include <hip/hip_runtime.h>
#include <hip/hip_cooperative_groups.h>
#include <cstdio>
namespace cg = cooperative_groups;
namespace pg8 {
#define PG8_LAS __attribute__((address_space(3)))
typedef unsigned short bf16_t;
typedef short bf16x8 __attribute__((ext_vector_type(8)));
typedef float f32x4 __attribute__((ext_vector_type(4)));
typedef unsigned u32x4 __attribute__((ext_vector_type(4)));
constexpr int BM = 256, BK = 64, HALF = 128, HTB = HALF * BK * 2  , STAGE_BYTES = 8 * HTB, NXCD = 8, WGM = 8;

__host__ __device__ __forceinline__ int lds_byte(int r, int c) { const int st = (r >> 4) * 2 + (c >> 5), rr = r & 15, cc = c & 31, ob = rr * 64 + cc * 2; return st * 1024 + (ob ^ (((ob >> 9) & 1) << 5)); }
__host__ __device__ __forceinline__ void stage_rc(int b, int& R, int& C) { const int st = b / 1024, sb = b % 1024, swz = sb ^ (((sb >> 9) & 1) << 5); R = (st >> 1) * 16 + swz / 64; C = (st & 1) * 32 + (swz % 64) / 2; }
__host__ __device__ __forceinline__ int perm32(int rho) { const int n = rho >> 4, i = rho & 15; return 8 * (i >> 2) + 4 * n + (i & 3); }

struct Unit { int pm, pn; };
struct Gemm { const bf16_t* A; const bf16_t* Bt; int M, N, K; int ld; size_t a_pm, b_pm; int perm; };

struct StaticOrder {
    int nM, nN, nwg, G, c;
    __host__ __device__ void init(int M, int N, int G_, int c_) { nM = M / BM; nN = N / BM; nwg = nM * nN; G = G_; c = c_; }
    __host__ __device__ bool next(int i, Unit& u) const {
        const long L = (long)i * G + c; if (L >= nwg) return false;
        int wgid = (int)L; { const int q = nwg / NXCD, r = nwg % NXCD, xcd = wgid % NXCD, off = wgid / NXCD; wgid = (xcd < r ? xcd * (q + 1) : r * (q + 1) + (xcd - r) * q) + off; }
        const int nig = WGM * nN, gid = wgid / nig, fm = gid * WGM, gsz = (nM - fm) < WGM ? (nM - fm) : WGM;
        u.pm = fm + ((wgid % nig) % gsz); u.pn = (wgid % nig) / gsz; return true;
    }
    __device__ __forceinline__ void a_ready(const Unit&) const {}
    __device__ __forceinline__ void done(const Unit&) const {}
};
__device__ __forceinline__ unsigned cvt_pk_bf16(float lo, float hi) { unsigned r; asm volatile("v_cvt_pk_bf16_f32 %0, %1, %2" : "=v"(r) : "v"(lo), "v"(hi)); return r; }
template <class Epi, class Sched, bool STAMP = false>
__device__ __forceinline__ void gemm_phase(PG8_LAS unsigned char* lds, const Gemm g, const Sched& S, const Epi& E, unsigned long long* stamps) {
    int tid_ = threadIdx.x; asm volatile("" : "+v"(tid_));
    const int tid = tid_, wid = __builtin_amdgcn_readfirstlane(tid >> 6), lane = tid & 63, wr = wid >> 2, wc = wid & 3, fr = lane & 15, fq = lane >> 4;
    const int K = g.K, nt = K / BK;
    int ts_lo = 0, ts_hi = 0, nts = 0; const unsigned long long rt_entry = STAMP ? (unsigned long long)wall_clock64() : 0ull;
#define PG8_STAMP() do { if (STAMP && wid == 0 && nts < 64) { const unsigned long long _c = (unsigned long long)clock64(); \
        ts_lo = (lane == nts) ? (int)(unsigned)_c : ts_lo; ts_hi = (lane == nts) ? (int)(unsigned)(_c >> 32) : ts_hi; ++nts; } } while (0)
    PG8_STAMP();
    unsigned voffA[2], voffB[2];
#pragma unroll
    for (int i = 0; i < 2; ++i) { int R, C; stage_rc(tid * 16 + i * 8192, R, C); const int Rb = g.perm ? ((R & ~31) + perm32(R & 31)) : R;
        voffA[i] = (unsigned)(R * g.ld + C) * 2u; voffB[i] = (unsigned)(Rb * g.ld + C) * 2u; }
    const size_t kstep = (size_t)(BK * 2);
    const size_t hstep = (size_t)HALF * g.ld * 2;
    const size_t tstep = 2 * hstep;
    const unsigned ldsw = (unsigned)wid * 1024u;
    const int aoff = lds_byte(wr * 64 + fr, fq * 8), boff = lds_byte(wc * 32 + fr, fq * 8);
#define PG8_SA(b, h) (((b) * 2 + (h)) * HTB)
#define PG8_SB(b, h) ((4 + (b) * 2 + (h)) * HTB)
#define PG8_STAGE(bufoff, gbase, voff) do { _Pragma("unroll") for (int _i = 0; _i < 2; ++_i) \
        __builtin_amdgcn_global_load_lds((const unsigned*)((const char*)(gbase) + (voff)[_i]), (PG8_LAS unsigned*)(lds + (bufoff) + ldsw + _i * 8192), 16, 0, 0); } while (0)
#define PG8_LDA(dst, b, h) do { _Pragma("unroll") for (int m = 0; m < 4; ++m) _Pragma("unroll") for (int k = 0; k < 2; ++k) dst[m][k] = *(const PG8_LAS bf16x8*)(lds + PG8_SA(b, h) + aoff + m * 2048 + k * 1024); } while (0)
#define PG8_LDB(dst, b, h) do { _Pragma("unroll") for (int n = 0; n < 2; ++n) _Pragma("unroll") for (int k = 0; k < 2; ++k) dst[n][k] = *(const PG8_LAS bf16x8*)(lds + PG8_SB(b, h) + boff + n * 2048 + k * 1024); } while (0)
#define PG8_MMA(ai, bj, At, Bt) do { __builtin_amdgcn_s_setprio(1); _Pragma("unroll") for (int m = 0; m < 4; ++m) _Pragma("unroll") for (int n = 0; n < 2; ++n) _Pragma("unroll") for (int k = 0; k < 2; ++k) \
        acc[ai][bj][m][n] = __builtin_amdgcn_mfma_f32_16x16x32_bf16(Bt[n][k], At[m][k], acc[ai][bj][m][n], 0, 0, 0); __builtin_amdgcn_s_setprio(0); } while (0)
#define PG8_WAIT_V(n) asm volatile("s_waitcnt vmcnt(" #n ")" ::: "memory")
#define PG8_WAIT_L(n) asm volatile("s_waitcnt lgkmcnt(" #n ")" ::: "memory")
#define PG8_BAR __builtin_amdgcn_s_barrier()
#define PG8_SCHED __builtin_amdgcn_sched_barrier(0)
    Unit cur, nxt; int ui = 0;
    if (!S.next(0, cur)) return;
    f32x4 acc[2][2][4][2];
#pragma unroll
    for (int a = 0; a < 2; ++a)
#pragma unroll
        for (int b = 0; b < 2; ++b)
#pragma unroll
            for (int m = 0; m < 4; ++m)
#pragma unroll
                for (int n = 0; n < 2; ++n) acc[a][b][m][n] = (f32x4){0.f, 0.f, 0.f, 0.f};
    bf16x8 At[4][2], B0[2][2], B1[2][2];
    const char* cA = (const char*)g.A + (size_t)cur.pm * g.a_pm; const char* cB = (const char*)g.Bt + (size_t)cur.pn * tstep + (size_t)cur.pm * g.b_pm;
    S.a_ready(cur);
    PG8_STAGE(PG8_SB(0, 0), cB, voffB); PG8_STAGE(PG8_SA(0, 0), cA, voffA); PG8_STAGE(PG8_SB(0, 1), cB + hstep, voffB); PG8_STAGE(PG8_SA(0, 1), cA + hstep, voffA);
    if (wr == 1) PG8_BAR;
    PG8_WAIT_V(4); PG8_BAR;
    PG8_STAGE(PG8_SB(1, 0), cB + kstep, voffB); PG8_STAGE(PG8_SA(1, 0), cA + kstep, voffA); PG8_STAGE(PG8_SB(1, 1), cB + hstep + kstep, voffB);
    PG8_WAIT_V(6); PG8_BAR;
    PG8_STAMP();
    for (;;) {
        const bool has_next = S.next(ui + 1, nxt);
        const char* nA = has_next ? (const char*)g.A + (size_t)nxt.pm * g.a_pm : cA; const char* nB = has_next ? (const char*)g.Bt + (size_t)nxt.pn * tstep + (size_t)nxt.pm * g.b_pm : cB;
        for (int t = 0; t < nt; t += 2) {
            const bool last = (t == nt - 2);
            const char* a1 = cA + (size_t)(t + 1) * kstep;
            const char* a2 = last ? nA : cA + (size_t)(t + 2) * kstep; const char* b2 = last ? nB : cB + (size_t)(t + 2) * kstep;
            const char* a3 = a2 + kstep; const char* b3 = b2 + kstep;
            if (last && has_next) S.a_ready(nxt);
            PG8_LDB(B0, 0, 0); PG8_SCHED; PG8_LDA(At, 0, 0); PG8_STAGE(PG8_SA(1, 1), a1 + hstep, voffA);
            PG8_WAIT_L(8); PG8_BAR; PG8_WAIT_L(0); PG8_MMA(0, 0, At, B0); PG8_BAR; PG8_SCHED;
            PG8_LDB(B1, 0, 1); PG8_STAGE(PG8_SB(0, 0), b2, voffB);
            PG8_BAR; PG8_WAIT_L(0); PG8_MMA(0, 1, At, B1); PG8_BAR;
            PG8_LDA(At, 0, 1); PG8_STAGE(PG8_SA(0, 0), a2, voffA);
            PG8_BAR; PG8_WAIT_L(0); PG8_MMA(1, 0, At, B0); PG8_BAR; PG8_SCHED;
            PG8_STAGE(PG8_SB(0, 1), b2 + hstep, voffB);
            PG8_WAIT_V(6); PG8_BAR; PG8_MMA(1, 1, At, B1); PG8_BAR;
            PG8_LDB(B0, 1, 0); PG8_SCHED; PG8_LDA(At, 1, 0); PG8_STAGE(PG8_SA(0, 1), a2 + hstep, voffA);
            PG8_WAIT_L(8); PG8_BAR; PG8_WAIT_L(0); PG8_MMA(0, 0, At, B0); PG8_BAR; PG8_SCHED;
            PG8_LDB(B1, 1, 1); PG8_STAGE(PG8_SB(1, 0), b3, voffB);
            PG8_BAR; PG8_WAIT_L(0); PG8_MMA(0, 1, At, B1); PG8_BAR;
            PG8_LDA(At, 1, 1); PG8_STAGE(PG8_SA(1, 0), a3, voffA);
            PG8_BAR; PG8_WAIT_L(0); PG8_MMA(1, 0, At, B0); PG8_BAR; PG8_SCHED;
            PG8_STAGE(PG8_SB(1, 1), b3 + hstep, voffB);
            PG8_WAIT_V(6); PG8_BAR; PG8_MMA(1, 1, At, B1); PG8_BAR;
        }
        PG8_STAMP();
        if constexpr (!Epi::AFTER_DRAIN) { E(acc, cur, wr, wc, fr, fq); S.done(cur); }
        PG8_STAMP();
        if (!has_next) break;
#pragma unroll
        for (int a = 0; a < 2; ++a)
#pragma unroll
            for (int b = 0; b < 2; ++b)
#pragma unroll
                for (int m = 0; m < 4; ++m)
#pragma unroll
                    for (int n = 0; n < 2; ++n) acc[a][b][m][n] = (f32x4){0.f, 0.f, 0.f, 0.f};
        cur = nxt; cA = nA; cB = nB; ++ui;
    }
    PG8_WAIT_V(0);
    if (wr == 0) PG8_BAR;
    PG8_BAR;
    if constexpr (Epi::AFTER_DRAIN) { E.fused(acc, cur, wr, wc, fr, fq, lds, wid, lane); S.done(cur); }
    PG8_STAMP();
    if (STAMP && wid == 0) { stamps[lane] = lane < nts ? (((unsigned long long)(unsigned)ts_hi << 32) | (unsigned)ts_lo) : 0ull;
        if (lane == 62) stamps[62] = rt_entry; if (lane == 63) stamps[63] = (unsigned long long)wall_clock64(); }
#undef PG8_STAMP
#undef PG8_SA
#undef PG8_SB
#undef PG8_STAGE
#undef PG8_LDA
#undef PG8_LDB
#undef PG8_MMA
#undef PG8_WAIT_V
#undef PG8_WAIT_L
#undef PG8_BAR
#undef PG8_SCHED
}
}
using pg8::bf16_t; using pg8::f32x4; using pg8::Unit; using pg8::Gemm; using pg8::StaticOrder; using pg8::cvt_pk_bf16;
#define DEVI __device__ __forceinline__
typedef _Float16 half_t;
typedef _Float16 h4 __attribute__((ext_vector_type(4)));
typedef _Float16 h8 __attribute__((ext_vector_type(8)));
typedef __fp16 fp2_t __attribute__((ext_vector_type(2)));

constexpr int DM = 1024, DFF = 2816, NB = 8, NMETA = 16, SEQ = 2048, LP = SEQ + NMETA, MP = NB * LP, NS = 128, M = MP + NS;
constexpr int DIN = 2304, S5G = 24, RH = 6, RPROJ = 1408;
constexpr int NC = 43, LC = 48;
static_assert(NC * LC == LP, "chunking");
static_assert(LP % 12 == 0 && MP + 12 <= M, "scan prefetch depth / over-read stays inside the row range");
static_assert(M % 256 == 0, "rows");
enum { I_XP = 0, I_XS, I_S5RE, I_S5IM, I_RWKV, I_SHIFT, I_LRU, I_CONV, I_META, I_F1N, I_F1G, I_F1U, I_F1D, I_MIXN, I_WIN,
       I_LAMRE, I_LAMIM, I_LOGDT, I_BRE, I_BIM, I_CRE, I_CIM, I_S5D, I_GLUW, I_GLUB,
       I_MU, I_W0, I_WUP, I_A0, I_AUP, I_GUP, I_KK, I_KA, I_RK, I_LNW, I_LNB,
       I_CW, I_CB, I_WA, I_BA, I_WX, I_BX, I_LAM, I_WOUT, I_F2N, I_F2G, I_F2U, I_F2D, I_FINN, N_IN };
constexpr size_t O_YP = 0, O_YS = O_YP + (size_t)NB * SEQ * DM, O_PS5RE = O_YS + (size_t)NS * DM, O_PS5IM = O_PS5RE + 2 * NB * 24 * 64,
    O_PRWKV = O_PS5IM + 2 * NB * 24 * 64, O_PSHIFT = O_PRWKV + (size_t)2 * NB * 6 * 4096, O_PLRU = O_PSHIFT + 2 * NB * 1408, O_PCONV = O_PLRU + 2 * NB * 256,
    O_SS5RE = O_PCONV + 2 * NB * 3 * 256, O_SS5IM = O_SS5RE + (size_t)2 * NS * 24 * 64, O_SRWKV = O_SS5IM + (size_t)2 * NS * 24 * 64,
    O_SSHIFT = O_SRWKV + (size_t)2 * NS * 6 * 4096, O_SLRU = O_SSHIFT + (size_t)2 * NS * 1408, O_SCONV = O_SLRU + (size_t)2 * NS * 256, O_END = O_SCONV + (size_t)2 * NS * 3 * 256;
static_assert(O_END == 25090048, "out size");
constexpr size_t SZ_WGU = 5632ull * 1024 * 2, SZ_WD = 1024ull * 2816 * 2, SZ_WIN = 2304ull * 1024 * 2, SZ_WOUT = 1024ull * 1024 * 2, SZ_WLR = 1280ull * 256 * 2,
    SZ_WLRU = 512ull * 256 * 2, SZ_WGLU = 512ull * 384 * 2;
constexpr size_t OFF_WGU = 0, OFF_WD = OFF_WGU + SZ_WGU, OFF_WIN = OFF_WD + SZ_WD, OFF_WOUT = OFF_WIN + SZ_WIN, OFF_WLR = OFF_WOUT + SZ_WOUT, OFF_WLRU = OFF_WLR + SZ_WLR,
    OFF_WGLU = OFF_WLRU + SZ_WLRU, OFF_H = OFF_WGLU + SZ_WGLU, OFF_XN = OFF_H + (size_t)M * DM * 4, OFF_BIG = OFF_XN + (size_t)M * DM * 2;
constexpr size_t OFF_MIX = OFF_XN, OFF_AX = OFF_XN, OFF_XC = OFF_AX + (size_t)M * 512, OFF_AA = OFF_XC + (size_t)M * 512;
static_assert(OFF_AA + (size_t)M * 768 <= OFF_BIG, "xn alias");
constexpr size_t OFF_ACT = OFF_BIG, OFF_PROJ = OFF_BIG, OFF_YR = OFF_PROJ + (size_t)M * DIN * 2, OFF_LA = OFF_YR + (size_t)M * 384 * 4, OFF_GX = OFF_LA + (size_t)M * 512,
    OFF_GG = OFF_GX + (size_t)M * 512, OFF_S5CS = OFF_GG + (size_t)M * 768, OFF_LCS = OFF_S5CS + (size_t)NB * 24 * NC * 128 * 4, OFF_END = OFF_LCS + (size_t)NB * NC * 256 * 2 * 4;
constexpr size_t OFF_PART = OFF_ACT + (size_t)M * DFF * 2;
static_assert(OFF_PART + 11ull * 256 * 1024 * 4 <= OFF_S5CS, "part");
constexpr size_t OFF_RL = OFF_WGU;
static_assert((size_t)M * 768 <= SZ_WGU + SZ_WD, "rl alias");
constexpr size_t OFF_GLR = OFF_LA;
static_assert((size_t)M * 768 <= (size_t)M * 1024, "glr alias");
constexpr size_t OFF_BAR = (OFF_END + 255) & ~(size_t)255, BAR_BYTES = 3456 * 4;
static_assert(OFF_BAR + BAR_BYTES <= 268435456ull, "workspace budget (256 MiB)");
static_assert(OFF_ACT + (size_t)M * DFF * 2 <= 268435456ull, "act");
constexpr size_t OOFF_RW = 0, OOFF_Z = (size_t)M * 3072;
static_assert(OOFF_Z + (size_t)M * 768 <= (size_t)NB * SEQ * DM * 4, "d_out scratch");

struct Params { const float* in[N_IN]; float* out; unsigned char* ws; };

DEVI float bf2f(bf16_t b) { return __uint_as_float(((unsigned)b) << 16); }
DEVI bf16_t f2bf(float f) { unsigned u = __float_as_uint(f); u += 0x7FFFu + ((u >> 16) & 1u); return (bf16_t)(u >> 16); }
DEVI float sigm(float x) { return __builtin_amdgcn_rcpf(1.f + __expf(-x)); }
DEVI float tanh_f(float x) { return 1.f - 2.f * __builtin_amdgcn_rcpf(1.f + __expf(2.f * x)); }
DEVI float log1p_small(float x) { return x < 0.03f ? x * (1.f - x * (0.5f - x * (0.33333334f - 0.25f * x))) : __logf(1.f + x); }
DEVI float logsig8(float lm) { return 8.0f * (fminf(lm, 0.f) - log1p_small(__expf(-fabsf(lm)))); }
DEVI float gelu_t(float x) { const float u = 0.7978845608f * (x + 0.044715f * x * x * x); return x * sigm(2.f * u); }
DEVI float wave_sum(float v) {
#pragma unroll
    for (int o = 32; o; o >>= 1) v += __shfl_xor(v, o);
    return v; }
template <int CTRL> DEVI float dppf(float v) { return __int_as_float(__builtin_amdgcn_mov_dpp(__float_as_int(v), CTRL, 0xf, 0xf, true)); }
DEVI float red16(float v) { v += dppf<0xB1>(v); v += dppf<0x4E>(v); v += dppf<0x141>(v); v += dppf<0x140>(v); return v; }

struct EpiSwiglu {
    static constexpr bool PERM = true, AFTER_DRAIN = false; bf16_t* act;
    DEVI void operator()(const f32x4 (&acc)[2][2][4][2], const Unit& u, int wr, int wc, int fr, int fq) const {
        const int row0 = u.pm * 256 + wr * 64 + fr, col = u.pn * 128 + wc * 32 + 8 * fq;
#pragma unroll
        for (int ai = 0; ai < 2; ++ai)
#pragma unroll
            for (int m = 0; m < 4; ++m) { bf16_t* rp = act + (size_t)(row0 + ai * 128 + m * 16) * DFF + col;
                float o[8];
#pragma unroll
                for (int n = 0; n < 2; ++n) { const f32x4 g = acc[ai][0][m][n], uu = acc[ai][1][m][n];
#pragma unroll
                    for (int i = 0; i < 4; ++i) o[4 * n + i] = g[i] * sigm(g[i]) * uu[i]; }
                uint4 w; w.x = cvt_pk_bf16(o[0], o[1]); w.y = cvt_pk_bf16(o[2], o[3]); w.z = cvt_pk_bf16(o[4], o[5]); w.w = cvt_pk_bf16(o[6], o[7]); *(uint4*)rp = w; }
    }
};
struct EpiResid {
    static constexpr bool PERM = false, AFTER_DRAIN = false; float* H; float scale; int row_base, pm_mul, atomic;
    DEVI void operator()(const f32x4 (&acc)[2][2][4][2], const Unit& u, int wr, int wc, int fr, int fq) const {
        const int row0 = row_base + u.pm * 256 * pm_mul + wr * 64 + fr, col0 = u.pn * 256 + wc * 32 + 4 * fq;
#pragma unroll
        for (int ai = 0; ai < 2; ++ai)
#pragma unroll
            for (int m = 0; m < 4; ++m) { float* rp = H + (size_t)(row0 + ai * 128 + m * 16) * DM + col0;
#pragma unroll
                for (int bj = 0; bj < 2; ++bj)
#pragma unroll
                    for (int n = 0; n < 2; ++n) { float* q = rp + bj * 128 + n * 16; const f32x4 a = acc[ai][bj][m][n] * scale;
                        if (atomic) *(f32x4*)q = a;
                        else { f32x4 v = *(f32x4*)q; v += a; *(f32x4*)q = v; } } }
    }
};
struct EpiF16 {
    static constexpr bool PERM = true, AFTER_DRAIN = false; half_t* O0; half_t* O1; half_t* O2; int ld0, ld12, ncols, segw, cs0;
    DEVI void operator()(const f32x4 (&acc)[2][2][4][2], const Unit& u, int wr, int wc, int fr, int fq) const {
        const int row0 = u.pm * 256 + wr * 64 + fr;
#pragma unroll
        for (int bj = 0; bj < 2; ++bj) { const int cb = u.pn * 256 + bj * 128; if (cb >= ncols) continue;
            half_t* base = O0; int ld = ld0, lc = cb, cm = cs0;
            if (segw) { const int seg = cb / segw; lc = cb - seg * segw; if (seg == 1) { base = O1; ld = ld12; cm = 1; } else if (seg == 2) { base = O2; ld = ld12; cm = 1; } }
            base += (lc + wc * 32 + 8 * fq) * cm;
#pragma unroll
            for (int ai = 0; ai < 2; ++ai)
#pragma unroll
                for (int m = 0; m < 4; ++m) { half_t* rp = base + (size_t)(row0 + ai * 128 + m * 16) * ld;
                    const h4 v0 = __builtin_convertvector(acc[ai][bj][m][0], h4), v1 = __builtin_convertvector(acc[ai][bj][m][1], h4);
                    if (cm == 1) *(h8*)rp = __builtin_shufflevector(v0, v1, 0, 1, 2, 3, 4, 5, 6, 7);
                    else { *(h4*)rp = v0; *(h4*)(rp + 4 * cm) = v1; } } }
    }
};
struct EpiAll {
    static constexpr bool PERM = false, AFTER_DRAIN = false; int mode; EpiSwiglu sw; EpiResid rs; EpiF16 f16;
    DEVI void operator()(const f32x4 (&acc)[2][2][4][2], const Unit& u, int wr, int wc, int fr, int fq) const {
        if (mode == 0) sw(acc, u, wr, wc, fr, fq); else if (mode == 1) rs(acc, u, wr, wc, fr, fq); else f16(acc, u, wr, wc, fr, fq);
    }
};
template <class Epi> DEVI void run_gemm(PG8_LAS unsigned char* lds, const bf16_t* A, const bf16_t* Bt, int Mrows, int N, int K, int ld, size_t a_pm, size_t b_pm, int perm, const Epi& E) {
    Gemm g; g.A = A; g.Bt = Bt; g.M = Mrows; g.N = N; g.K = K; g.ld = ld; g.a_pm = a_pm; g.b_pm = b_pm; g.perm = perm;
    int bid_ = blockIdx.x; asm volatile("" : "+s"(bid_));
    StaticOrder S; S.init(Mrows, N, (int)gridDim.x, bid_);
    pg8::gemm_phase<Epi, StaticOrder, false>(lds, g, S, E, nullptr);
}
#define LAUNDER_IDS int TIDX = threadIdx.x; asm volatile("" : "+v"(TIDX)); int BIDX = blockIdx.x; asm volatile("" : "+s"(BIDX))
template <class F> DEVI void conv_w(bf16_t* dst, int N, int K, float* tile, int rot, F src) { LAUNDER_IDS;
    const int ntk = K / 64, nt = (N / 64) * ntk; const int tx = TIDX & 63, ty = TIDX >> 6, rr = TIDX >> 3, kc = TIDX & 7;
    const int G = (int)gridDim.x;
    for (int t = (int)((BIDX + G - (rot % G)) % G); t < nt; t += 2 * G) {
        const int t2 = t + G; const bool has2 = t2 < nt;
        const int r0 = (t / ntk) * 64, k0 = (t % ntk) * 64, r1 = has2 ? (t2 / ntk) * 64 : r0, k1 = has2 ? (t2 % ntk) * 64 : k0;
        float va[8], vb[8];
#pragma unroll
        for (int q = 0; q < 8; ++q) { va[q] = src(k0 + ty + 8 * q, r0 + tx); vb[q] = src(k1 + ty + 8 * q, r1 + tx); }
#pragma unroll
        for (int q = 0; q < 8; ++q) { tile[(ty + 8 * q) * 65 + tx] = va[q]; tile[64 * 65 + (ty + 8 * q) * 65 + tx] = vb[q]; }
        __syncthreads();
#pragma unroll
        for (int h = 0; h < 2; ++h) { if (h == 1 && !has2) break; const float* tl = tile + h * 64 * 65;
            uint4 w; w.x = cvt_pk_bf16(tl[(kc * 8 + 0) * 65 + rr], tl[(kc * 8 + 1) * 65 + rr]); w.y = cvt_pk_bf16(tl[(kc * 8 + 2) * 65 + rr], tl[(kc * 8 + 3) * 65 + rr]);
            w.z = cvt_pk_bf16(tl[(kc * 8 + 4) * 65 + rr], tl[(kc * 8 + 5) * 65 + rr]); w.w = cvt_pk_bf16(tl[(kc * 8 + 6) * 65 + rr], tl[(kc * 8 + 7) * 65 + rr]);
            *(uint4*)(dst + (size_t)((h ? r1 : r0) + rr) * K + (h ? k1 : k0) + kc * 8) = w; }
        __syncthreads();
    }
}
DEVI void conv_ffn(const Params& p, int l, int which, float* tile) {
    const float* wg = p.in[which ? I_F2G : I_F1G] + (size_t)l * DM * DFF; const float* wu = p.in[which ? I_F2U : I_F1U] + (size_t)l * DM * DFF;
    const float* wd = p.in[which ? I_F2D : I_F1D] + (size_t)l * DFF * DM;
    const ptrdiff_t dgu = wu - wg;
    conv_w((bf16_t*)(p.ws + OFF_WGU), 2 * DFF, DM, tile, 0, [=](int k, int r) { const int q = r >> 8, s = r & 255; return __builtin_nontemporal_load(wg + ((s < 128 ? (ptrdiff_t)0 : dgu) + (ptrdiff_t)k * DFF + q * 128 + (s & 127))); });
    conv_w((bf16_t*)(p.ws + OFF_WD), DM, DFF, tile, 128, [=](int k, int r) { return __builtin_nontemporal_load(wd + ((size_t)k * DM + r)); });
}
DEVI void conv_mix(const Params& p, int l, float* tile) {
    const float* win = p.in[I_WIN] + (size_t)l * DM * DIN; const float* wout = p.in[I_WOUT] + (size_t)l * DM * DM;
    const float* wup = p.in[I_WUP] + (size_t)l * 64 * 384; const float* aup = p.in[I_AUP] + (size_t)l * 64 * 384; const float* gup = p.in[I_GUP] + (size_t)l * 128 * 384;
    const float* wa = p.in[I_WA] + (size_t)l * 4 * 64 * 64; const float* wx = p.in[I_WX] + (size_t)l * 4 * 64 * 64; const float* glu = p.in[I_GLUW] + (size_t)l * 384 * 384;
    conv_w((bf16_t*)(p.ws + OFF_WIN), DIN, DM, tile, 64, [=](int k, int r) { return __builtin_nontemporal_load(win + ((size_t)k * DIN + r)); });
    conv_w((bf16_t*)(p.ws + OFF_WOUT), DM, DM, tile, 192, [=](int k, int r) { return __builtin_nontemporal_load(wout + ((size_t)k * DM + r)); });
    conv_w((bf16_t*)(p.ws + OFF_WLR), 1280, 256, tile, 0, [=](int k, int r) {
        float v = 0.f;
        if (r < 384) { if (k < 64) v = wup[k * 384 + r]; }
        else if (r < 768) { if (k >= 64 && k < 128) v = aup[(k - 64) * 384 + (r - 384)]; }
        else if (r < 1152) { if (k >= 128) v = gup[(k - 128) * 384 + (r - 768)]; }
        return v; });
    const ptrdiff_t dax = wx - wa;
    conv_w((bf16_t*)(p.ws + OFF_WLRU), 512, 256, tile, 80, [=](int k, int r) {
        const int rr2 = r & 255, hb = rr2 >> 6, j = rr2 & 63; float v = 0.f;
        if ((k >> 6) == hb) v = wa[(r < 256 ? (ptrdiff_t)0 : dax) + (hb * 64 + (k & 63)) * 64 + j];
        return v; });
    conv_w((bf16_t*)(p.ws + OFF_WGLU), 512, 384, tile, 112, [=](int k, int r) { return r < 384 ? glu[k * 384 + r] : 0.f; });
}

template <int MODE> DEVI void norm_phase(const Params& p, const float* gamma, int nsl = 0, const half_t* D = nullptr, float dscale = 0.f) { LAUNDER_IDS;
    const int wid = TIDX >> 6, lane = TIDX & 63, gw = BIDX * 8 + wid, nw = gridDim.x * 8;
    float* H = (float*)(p.ws + OFF_H); bf16_t* XN = (bf16_t*)(p.ws + OFF_XN);
    float4 gm[4];
#pragma unroll
    for (int i = 0; i < 4; ++i) gm[i] = *(const float4*)(gamma + i * 256 + lane * 4);
    auto srcp = [&](int r) -> const float* {
        const bool samp = r >= MP; const int b = r / LP, t = r - b * LP;
        if (MODE == 0) return samp ? p.in[I_XS] + (size_t)(r - MP) * DM : (t < NMETA ? p.in[I_META] + (size_t)t * DM : p.in[I_XP] + ((size_t)b * SEQ + (t - NMETA)) * DM);
        return H + (size_t)r * DM; };
    auto process = [&](int r, float4 (&v)[4], const h4 (&d)[4]) {
        const bool samp = r >= MP; const int b = r / LP, t = r - b * LP;
        float ss = 0.f;
        if (MODE != 0 && D && r < 16384) {
#pragma unroll
            for (int i = 0; i < 4; ++i) { v[i].x = fmaf(dscale, (float)d[i][0], v[i].x); v[i].y = fmaf(dscale, (float)d[i][1], v[i].y); v[i].z = fmaf(dscale, (float)d[i][2], v[i].z); v[i].w = fmaf(dscale, (float)d[i][3], v[i].w);
                if (MODE == 1) __builtin_nontemporal_store((f32x4){v[i].x, v[i].y, v[i].z, v[i].w}, (f32x4*)(H + (size_t)r * DM + i * 256 + lane * 4)); }
        }
#pragma unroll
        for (int i = 0; i < 4; ++i) ss += v[i].x * v[i].x + v[i].y * v[i].y + v[i].z * v[i].z + v[i].w * v[i].w;
        if (MODE != 0 && nsl > 0 && r >= 16384) {
            const float* part = (const float*)(p.ws + OFF_PART) + (size_t)(r - 16384) * DM; ss = 0.f;
            for (int sl = 0; sl < nsl; ++sl) {
#pragma unroll
                for (int i = 0; i < 4; ++i) { const float4 q = *(const float4*)(part + (size_t)sl * 256 * DM + i * 256 + lane * 4); v[i].x += q.x; v[i].y += q.y; v[i].z += q.z; v[i].w += q.w; } }
#pragma unroll
            for (int i = 0; i < 4; ++i) { ss += v[i].x * v[i].x + v[i].y * v[i].y + v[i].z * v[i].z + v[i].w * v[i].w; if (MODE == 1) *(float4*)(H + (size_t)r * DM + i * 256 + lane * 4) = v[i]; }
        }
        ss = wave_sum(ss); const float rs = rsqrtf(ss * (1.0f / DM) + 1e-6f);
        if (MODE == 0) {
#pragma unroll
            for (int i = 0; i < 4; ++i) *(float4*)(H + (size_t)r * DM + i * 256 + lane * 4) = v[i];
        }
        if (MODE != 2) {
#pragma unroll
            for (int i = 0; i < 4; ++i) { uint2 w; w.x = cvt_pk_bf16(v[i].x * rs * gm[i].x, v[i].y * rs * gm[i].y); w.y = cvt_pk_bf16(v[i].z * rs * gm[i].z, v[i].w * rs * gm[i].w);
                *(uint2*)(XN + (size_t)r * DM + i * 256 + lane * 4) = w; }
        } else {
            float* dst = nullptr;
            if (samp) dst = p.out + O_YS + (size_t)(r - MP) * DM; else if (t >= NMETA) dst = p.out + O_YP + ((size_t)b * SEQ + (t - NMETA)) * DM;
            if (dst) {
#pragma unroll
                for (int i = 0; i < 4; ++i) { float4 o; o.x = v[i].x * rs * gm[i].x; o.y = v[i].y * rs * gm[i].y; o.z = v[i].z * rs * gm[i].z; o.w = v[i].w * rs * gm[i].w; __builtin_nontemporal_store((f32x4){o.x, o.y, o.z, o.w}, (f32x4*)(dst + i * 256 + lane * 4)); }
            }
        }
    };
    for (int r = gw; r < M; r += 2 * nw) {
        const int r2 = r + nw; const bool has2 = r2 < M;
        const float* s1 = srcp(r); const float* s2 = srcp(has2 ? r2 : r);
        float4 va[4], vb[4]; h4 da[4], db[4];
#pragma unroll
        for (int i = 0; i < 4; ++i) { const f32x4 ta = __builtin_nontemporal_load((const f32x4*)(s1 + i * 256 + lane * 4)), tb = __builtin_nontemporal_load((const f32x4*)(s2 + i * 256 + lane * 4));
            va[i] = make_float4(ta[0], ta[1], ta[2], ta[3]); vb[i] = make_float4(tb[0], tb[1], tb[2], tb[3]); da[i] = (h4){0, 0, 0, 0}; db[i] = da[i]; }
        if (MODE != 0 && D) {
            const int ra = r < 16384 ? r : 0, rb = (has2 && r2 < 16384) ? r2 : 0;
#pragma unroll
            for (int i = 0; i < 4; ++i) { da[i] = __builtin_nontemporal_load((const h4*)(D + (size_t)ra * DM + i * 256 + lane * 4)); db[i] = __builtin_nontemporal_load((const h4*)(D + (size_t)rb * DM + i * 256 + lane * 4)); }
        }
        process(r, va, da);
        if (has2) process(r2, vb, db);
    }
}

template <int CARRY> DEVI void s5_item(const Params& p, int l, int g, int seq, int j, float* ldsH, int lane) {
    constexpr bool OUT = CARRY != 0;
    const half_t* PROJ = (const half_t*)(p.ws + OFF_PROJ); float* CS = (float*)(p.ws + OFF_S5CS); bf16_t* Z = (bf16_t*)((unsigned char*)p.out + OOFF_Z);
    const int n = lane, lg = l * 24 + g;
    const float lr = p.in[I_LAMRE][lg * 64 + n], li = p.in[I_LAMIM][lg * 64 + n], dt = expf(p.in[I_LOGDT][lg]);
    const float mag = expf(lr * dt); float sn, cs; sincosf(li * dt, &sn, &cs); const float abr = mag * cs, abi = mag * sn;
    const float den = lr * lr + li * li, fre = ((abr - 1.f) * lr + abi * li) / den, fim = (abi * lr - (abr - 1.f) * li) / den;
    float Br[16], Bi[16];
    { const float4* br = (const float4*)(p.in[I_BRE] + (size_t)(lg * 64 + n) * 16); const float4* bi = (const float4*)(p.in[I_BIM] + (size_t)(lg * 64 + n) * 16);
#pragma unroll
      for (int q = 0; q < 4; ++q) { const float4 a = br[q], b = bi[q];
          Br[4 * q + 0] = fre * a.x - fim * b.x; Bi[4 * q + 0] = fre * b.x + fim * a.x; Br[4 * q + 1] = fre * a.y - fim * b.y; Bi[4 * q + 1] = fre * b.y + fim * a.y;
          Br[4 * q + 2] = fre * a.z - fim * b.z; Bi[4 * q + 2] = fre * b.z + fim * a.z; Br[4 * q + 3] = fre * a.w - fim * b.w; Bi[4 * q + 3] = fre * b.w + fim * a.w; } }
    fp2_t Bpr[8], Bpi[8];
#pragma unroll
    for (int c2 = 0; c2 < 8; ++c2) { Bpr[c2] = (fp2_t){(__fp16)Br[2 * c2], (__fp16)Br[2 * c2 + 1]}; Bpi[c2] = (fp2_t){(__fp16)Bi[2 * c2], (__fp16)Bi[2 * c2 + 1]}; }
    const int tt = lane & 15, cq = lane >> 4;
    float Cm[32]; float dsk[4];
    if (OUT) {
        const float* cre = p.in[I_CRE] + (size_t)(lg * 16 + tt) * 64; const float* cim = p.in[I_CIM] + (size_t)(lg * 16 + tt) * 64;
#pragma unroll
        for (int s = 0; s < 16; ++s) { Cm[s] = cre[4 * s + cq]; Cm[16 + s] = -cim[4 * s + cq]; }
#pragma unroll
        for (int i = 0; i < 4; ++i) dsk[i] = p.in[I_S5D][l * 384 + g * 16 + cq * 4 + i];
    }
    int row0, ntok; float hr = 0.f, hi = 0.f;
    if (CARRY == 2) { row0 = MP + seq; ntok = 1; hr = p.in[I_S5RE][((size_t)(l * NS + seq) * 24 + g) * 64 + n]; hi = p.in[I_S5IM][((size_t)(l * NS + seq) * 24 + g) * 64 + n]; }
    else { row0 = seq * LP + j * LC; ntok = LC; }
    if (CARRY == 1) {
        float Lr = 1.f, Li = 0.f;
        for (int i = 0; i < LC; ++i) { const float a = Lr * abr - Li * abi, b = Lr * abi + Li * abr; Lr = a; Li = b; }
        const float* cs0 = CS + (size_t)((seq * 24 + g) * NC) * 128 + n;
        for (int i0 = 0; i0 < j; i0 += 8) { float er[8], ei[8];
#pragma unroll
            for (int u = 0; u < 8; ++u) { const int ii = min(i0 + u, j - 1); er[u] = cs0[(size_t)ii * 128]; ei[u] = cs0[(size_t)ii * 128 + 64]; }
#pragma unroll
            for (int u = 0; u < 8; ++u) { const bool ok = (i0 + u) < j; const float mr = ok ? Lr : 1.f, mi = ok ? Li : 0.f, ar = ok ? er[u] : 0.f, ai = ok ? ei[u] : 0.f;
                const float a = hr * mr - hi * mi + ar, b = hr * mi + hi * mr + ai; hr = a; hi = b; } }
    }
    for (int tb = 0; tb < ntok; tb += 16) {
        const int ti = min(tb + tt, ntok - 1); const size_t row = (size_t)(row0 + ti);
        const h4 uh = *(const h4*)(PROJ + row * DIN + g * 16 + cq * 4);
        float uf[4]; const int2 uhw = __builtin_bit_cast(int2, uh);
#pragma unroll
        for (int i = 0; i < 4; ++i) uf[i] = (float)uh[i];
#pragma unroll
        for (int t2 = 0; t2 < 16; ++t2) {
            if (tb + t2 < ntok) {
                float xr = 0.f, xi = 0.f;
#pragma unroll
                for (int c2 = 0; c2 < 8; ++c2) { const fp2_t up = __builtin_bit_cast(fp2_t, __builtin_amdgcn_readlane((c2 & 1) ? uhw.y : uhw.x, (c2 >> 1) * 16 + t2));
                    xr = __builtin_amdgcn_fdot2(Bpr[c2], up, xr, false); xi = __builtin_amdgcn_fdot2(Bpi[c2], up, xi, false); }
                const float a = abr * hr - abi * hi + xr, b = abr * hi + abi * hr + xi; hr = a; hi = b;
            }
            if (OUT) { ldsH[n * 17 + t2] = hr; ldsH[(64 + n) * 17 + t2] = hi; }
        }
        if (OUT) {
            __builtin_amdgcn_fence(__ATOMIC_RELEASE, "wavefront"); __builtin_amdgcn_wave_barrier(); __builtin_amdgcn_fence(__ATOMIC_ACQUIRE, "wavefront");
            f32x4 acc = (f32x4){0.f, 0.f, 0.f, 0.f};
#pragma unroll
            for (int s = 0; s < 32; ++s) acc = __builtin_amdgcn_mfma_f32_16x16x4f32(Cm[s], ldsH[(4 * s + cq) * 17 + tt], acc, 0, 0, 0);
            float z[4];
#pragma unroll
            for (int i = 0; i < 4; ++i) z[i] = gelu_t(acc[i] + dsk[i] * uf[i]);
            if (tb + tt < ntok) { uint2 w; w.x = cvt_pk_bf16(z[0], z[1]); w.y = cvt_pk_bf16(z[2], z[3]); *(uint2*)(Z + row * 384 + g * 16 + cq * 4) = w; }
            __builtin_amdgcn_fence(__ATOMIC_RELEASE, "wavefront"); __builtin_amdgcn_wave_barrier(); __builtin_amdgcn_fence(__ATOMIC_ACQUIRE, "wavefront");
        }
    }
    if (CARRY == 0) { float* o = CS + (size_t)((seq * 24 + g) * NC + j) * 128 + n; o[0] = hr; o[64] = hi; }
    if (CARRY == 1 && j == NC - 1) { p.out[O_PS5RE + ((size_t)(l * NB + seq) * 24 + g) * 64 + n] = hr; p.out[O_PS5IM + ((size_t)(l * NB + seq) * 24 + g) * 64 + n] = hi; }
    if (CARRY == 2) { p.out[O_SS5RE + ((size_t)(l * NS + seq) * 24 + g) * 64 + n] = hr; p.out[O_SS5IM + ((size_t)(l * NS + seq) * 24 + g) * 64 + n] = hi; }
}

DEVI float rw_prev(const Params& p, int l, const half_t* PROJ, int row, int jcol) {
    if (row >= MP) return p.in[I_SHIFT][(size_t)(l * NS + (row - MP)) * RPROJ + jcol];
    const int t = row % LP; return t == 0 ? 0.f : (float)PROJ[(size_t)(row - 1) * DIN + 384 + jcol];
}


DEVI void rw_prev4(const Params& p, int l, const half_t* PROJ, int row, int jcol, float (&o)[4]) {
    if (row >= MP) { const float4 v = *(const float4*)(p.in[I_SHIFT] + (size_t)(l * NS + (row - MP)) * RPROJ + jcol); o[0] = v.x; o[1] = v.y; o[2] = v.z; o[3] = v.w; return; }
    const int t = row % LP;
    if (t == 0) { o[0] = o[1] = o[2] = o[3] = 0.f; return; }
    const h4 v = *(const h4*)(PROJ + (size_t)(row - 1) * DIN + 384 + jcol); o[0] = (float)v[0]; o[1] = (float)v[1]; o[2] = (float)v[2]; o[3] = (float)v[3];
}
DEVI void phase_m1a(const Params& p, int l, float* lds) { LAUNDER_IDS;
    const half_t* PROJ = (const half_t*)(p.ws + OFF_PROJ); bf16_t* AX = (bf16_t*)(p.ws + OFF_AX); bf16_t* XC = (bf16_t*)(p.ws + OFF_XC);
    const float* mu = p.in[I_MU] + l * RPROJ; const float* cw = p.in[I_CW] + l * 4 * 256; const float* cb = p.in[I_CB] + l * 256;
    const int wid = TIDX >> 6, lane = TIDX & 63, c4 = lane * 4;
    float4 mu4, cb4, cw4[4];
    mu4 = *(const float4*)(mu + 1152 + c4); cb4 = *(const float4*)(cb + c4);
#pragma unroll
    for (int j = 0; j < 4; ++j) cw4[j] = *(const float4*)(cw + j * 256 + c4);
    const float muv[4] = {mu4.x, mu4.y, mu4.z, mu4.w}, cbv[4] = {cb4.x, cb4.y, cb4.z, cb4.w};
    for (int row = BIDX * 8 + wid; row < M; row += gridDim.x * 8) {
        const bool samp = row >= MP; const int b = row / LP, t = row - b * LP, sq = row - MP;
        const half_t* pr = PROJ + (size_t)row * DIN;
        { const h4 pv = *(const h4*)(pr + 384 + 1152 + c4); float pp[4]; rw_prev4(p, l, PROJ, row, 1152 + c4, pp); float o[4];
#pragma unroll
          for (int i = 0; i < 4; ++i) { const float x = (float)pv[i]; const float xm = x + (pp[i] - x) * muv[i]; o[i] = c4 < 64 ? tanh_f(xm) : (c4 < 128 ? xm : sigm(xm)); }
          uint2 w; w.x = cvt_pk_bf16(o[0], o[1]); w.y = cvt_pk_bf16(o[2], o[3]); *(uint2*)(AX + (size_t)row * 256 + c4) = w; }
        const h4 x0h = *(const h4*)(pr + 1792 + c4); float x0[4], xm1[4], xm2[4], xm3[4];
#pragma unroll
        for (int i = 0; i < 4; ++i) x0[i] = (float)x0h[i];
        if (samp) { const float* c0 = p.in[I_CONV] + (size_t)(l * NS + sq) * 3 * 256 + c4; const float4 a3 = *(const float4*)c0, a2 = *(const float4*)(c0 + 256), a1 = *(const float4*)(c0 + 512);
            xm3[0] = a3.x; xm3[1] = a3.y; xm3[2] = a3.z; xm3[3] = a3.w; xm2[0] = a2.x; xm2[1] = a2.y; xm2[2] = a2.z; xm2[3] = a2.w; xm1[0] = a1.x; xm1[1] = a1.y; xm1[2] = a1.z; xm1[3] = a1.w; }
        else { h4 h1 = (h4){0, 0, 0, 0}, h2 = h1, h3 = h1;
            if (t >= 1) h1 = *(const h4*)(pr + 1792 + c4 - DIN); if (t >= 2) h2 = *(const h4*)(pr + 1792 + c4 - 2 * DIN); if (t >= 3) h3 = *(const h4*)(pr + 1792 + c4 - 3 * DIN);
#pragma unroll
            for (int i = 0; i < 4; ++i) { xm1[i] = (float)h1[i]; xm2[i] = (float)h2[i]; xm3[i] = (float)h3[i]; } }
        { const float w0v[4] = {cw4[0].x, cw4[0].y, cw4[0].z, cw4[0].w}, w1v[4] = {cw4[1].x, cw4[1].y, cw4[1].z, cw4[1].w}, w2v[4] = {cw4[2].x, cw4[2].y, cw4[2].z, cw4[2].w}, w3v[4] = {cw4[3].x, cw4[3].y, cw4[3].z, cw4[3].w};
          float o[4];
#pragma unroll
          for (int i = 0; i < 4; ++i) o[i] = cbv[i] + w0v[i] * xm3[i] + w1v[i] * xm2[i] + w2v[i] * xm1[i] + w3v[i] * x0[i];
          uint2 w; w.x = cvt_pk_bf16(o[0], o[1]); w.y = cvt_pk_bf16(o[2], o[3]); *(uint2*)(XC + (size_t)row * 256 + c4) = w; }
        if (samp) {
            float* so = p.out + O_SSHIFT + (size_t)(l * NS + sq) * RPROJ;
            for (int j = c4; j < RPROJ; j += 256) { const h4 v = *(const h4*)(pr + 384 + j); *(float4*)(so + j) = make_float4((float)v[0], (float)v[1], (float)v[2], (float)v[3]); }
            float* co = p.out + O_SCONV + (size_t)(l * NS + sq) * 3 * 256 + c4;
            *(float4*)co = make_float4(xm2[0], xm2[1], xm2[2], xm2[3]); *(float4*)(co + 256) = make_float4(xm1[0], xm1[1], xm1[2], xm1[3]); *(float4*)(co + 512) = make_float4(x0[0], x0[1], x0[2], x0[3]);
        } else if (t >= LP - 3) {
            *(float4*)(p.out + O_PCONV + ((size_t)(l * NB + b) * 3 + (t - (LP - 3))) * 256 + c4) = make_float4(x0[0], x0[1], x0[2], x0[3]);
            if (t == LP - 1) { float* so = p.out + O_PSHIFT + (size_t)(l * NB + b) * RPROJ;
                for (int j = c4; j < RPROJ; j += 256) { const h4 v = *(const h4*)(pr + 384 + j); *(float4*)(so + j) = make_float4((float)v[0], (float)v[1], (float)v[2], (float)v[3]); } }
        }
    }
    for (int it = BIDX * 8 + wid; it < NB * 24 * NC; it += gridDim.x * 8) { const int j = it % NC, sg = it / NC; s5_item<0>(p, l, sg % 24, sg / 24, j, lds, lane); }
}

DEVI void phase_m1c(const Params& p, int l) { LAUNDER_IDS;
    const half_t* PROJ = (const half_t*)(p.ws + OFF_PROJ); const half_t* AA = (const half_t*)(p.ws + OFF_AA); half_t* RW = (half_t*)((unsigned char*)p.out + OOFF_RW);
    const float* mu = p.in[I_MU] + l * RPROJ; const int wid = TIDX >> 6, lane = TIDX & 63;
    struct RwIn { h4 pv, aa, wr0, prr; float pp[4], ppr[4]; float4 mu4, kk4, ka4, a04, w04, mur4; half_t* o; half_t* rl; };
    auto rw_load = [&](int it, RwIn& q) {
        const int pair = it * 4 + (lane >> 4), row = pair / RH, h = pair - row * RH, col = h * 64 + (lane & 15) * 4;
        q.pv = *(const h4*)(PROJ + (size_t)row * DIN + 768 + col); rw_prev4(p, l, PROJ, row, 384 + col, q.pp);
        q.aa = *(const h4*)(AA + (size_t)row * 384 + col); q.o = RW + (size_t)row * 1536 + col * 4; q.wr0 = *(const h4*)q.o;
        q.mu4 = *(const float4*)(mu + 384 + col); q.kk4 = *(const float4*)(p.in[I_KK] + l * 384 + col); q.ka4 = *(const float4*)(p.in[I_KA] + l * 384 + col);
        q.a04 = *(const float4*)(p.in[I_A0] + l * 384 + col); q.w04 = *(const float4*)(p.in[I_W0] + l * 384 + col);
        q.prr = *(const h4*)(PROJ + (size_t)row * DIN + 384 + col); rw_prev4(p, l, PROJ, row, col, q.ppr); q.mur4 = *(const float4*)(mu + col); q.rl = (half_t*)(p.ws + OFF_RL) + (size_t)row * 384 + col; };
    auto rw_finish = [&](const RwIn& q) {
        const float muv[4] = {q.mu4.x, q.mu4.y, q.mu4.z, q.mu4.w}, kkv[4] = {q.kk4.x, q.kk4.y, q.kk4.z, q.kk4.w}, kav[4] = {q.ka4.x, q.ka4.y, q.ka4.z, q.ka4.w},
                    a0v[4] = {q.a04.x, q.a04.y, q.a04.z, q.a04.w}, w0v[4] = {q.w04.x, q.w04.y, q.w04.z, q.w04.w};
        float kraw[4], a[4], kkr[4], ss = 0.f;
#pragma unroll
        for (int i = 0; i < 4; ++i) { const float x = (float)q.pv[i]; kraw[i] = x + (q.pp[i] - x) * muv[i]; a[i] = sigm(a0v[i] + (float)q.aa[i]); kkr[i] = kraw[i] * kkv[i]; ss = fmaf(kkr[i], kkr[i], ss); }
        ss = red16(ss); const float inv = 1.f / fmaxf(sqrtf(ss), 1e-12f);
        h4 oo, okp, okk, oka;
#pragma unroll
        for (int i = 0; i < 4; ++i) { const float e = sigm(w0v[i] + (float)q.wr0[i]) * 0.6065306597f; const float kk = kkr[i] * inv;
            oo[i] = (half_t)(1.f - __expf(-e)); okp[i] = (half_t)(kraw[i] * (1.f + (a[i] - 1.f) * kav[i])); okk[i] = (half_t)kk; oka[i] = (half_t)(kk * a[i]); }
        *(h4*)q.o = oo; *(h4*)(q.o + 4) = okk; { h8 pk; pk[0] = okp[0]; pk[1] = oka[0]; pk[2] = okp[1]; pk[3] = oka[1]; pk[4] = okp[2]; pk[5] = oka[2]; pk[6] = okp[3]; pk[7] = oka[3]; *(h8*)(q.o + 8) = pk; }
        { const float mr[4] = {q.mur4.x, q.mur4.y, q.mur4.z, q.mur4.w}; h4 orl;
#pragma unroll
          for (int i = 0; i < 4; ++i) { const float x = (float)q.prr[i]; orl[i] = (half_t)(x + (q.ppr[i] - x) * mr[i]); }
          *(h4*)q.rl = orl; } };
    { const int nit = M * RH / 4, st = gridDim.x * 8;
      for (int it = BIDX * 8 + wid; it < nit; it += 2 * st) {
          const bool has2 = it + st < nit; RwIn qa, qb; rw_load(it, qa); rw_load(has2 ? it + st : it, qb);
          rw_finish(qa); if (has2) rw_finish(qb); } }
    const half_t* LA = (const half_t*)(p.ws + OFF_LA); const half_t* GX = (const half_t*)(p.ws + OFF_GX); float* LCS = (float*)(p.ws + OFF_LCS);
    const float* cw = p.in[I_CW] + l * 4 * 256; const float* cb = p.in[I_CB] + l * 256;
    for (int id = BIDX * blockDim.x + TIDX; id < NB * NC * 256; id += gridDim.x * blockDim.x) {
        const int c = id & 255, bj = id >> 8, j = bj % NC, b = bj / NC, t0 = j * LC; const size_t row0 = (size_t)b * LP + t0;
        const half_t* px = PROJ + row0 * DIN + 1792 + c;
        float xm1 = t0 >= 1 ? (float)px[-DIN] : 0.f, xm2 = t0 >= 2 ? (float)px[-2 * DIN] : 0.f, xm3 = t0 >= 3 ? (float)px[-3 * DIN] : 0.f;
        const float w0 = cw[c], w1 = cw[256 + c], w2 = cw[512 + c], w3 = cw[768 + c], bb = cb[c];
        const float lmv = p.in[I_LAM][l * 256 + c], ls8 = logsig8(lmv), bav = p.in[I_BA][l * 256 + c], bxv = p.in[I_BX][l * 256 + c];
        float A = 1.f, hh = 0.f;
        for (int t8 = 0; t8 < LC; t8 += 8) { half_t xh[8], lh[8], gh[8];
#pragma unroll
            for (int u = 0; u < 8; ++u) { xh[u] = px[(size_t)(t8 + u) * DIN]; lh[u] = LA[(row0 + t8 + u) * 256 + c]; gh[u] = GX[(row0 + t8 + u) * 256 + c]; }
#pragma unroll
            for (int u = 0; u < 8; ++u) { const float x0 = (float)xh[u]; const float la = sigm((float)lh[u] + bav) * ls8, gx = sigm((float)gh[u] + bxv);
                const float xc = bb + w0 * xm3 + w1 * xm2 + w2 * xm1 + w3 * x0; const float a = __expf(la); const float bm = sqrtf(fmaxf(1.f - __expf(2.f * la), 0.f));
                hh = a * hh + bm * gx * xc; A *= a; xm3 = xm2; xm2 = xm1; xm1 = x0; } }
        LCS[(size_t)id * 2] = A; LCS[(size_t)id * 2 + 1] = hh;
    }
}
DEVI float rwkv_step(float (&S)[4], const h4 om, const h4 kk, const h8 kpka, const float (&r)[4], float v) {
    float sa = 0.f;
#pragma unroll
    for (int i = 0; i < 4; ++i) sa = fmaf(-S[i], (float)kk[i], sa);
    float tmp[4];
#pragma unroll
    for (int i = 0; i < 4; ++i) tmp[i] = fmaf(-(float)om[i], S[i], S[i]);
    sa = red16(sa);
    const fp2_t vs = __builtin_amdgcn_cvt_pkrtz(v, sa);
    const uint4 pk = __builtin_bit_cast(uint4, kpka);
    S[0] = __builtin_amdgcn_fdot2(__builtin_bit_cast(fp2_t, pk.x), vs, tmp[0], false); S[1] = __builtin_amdgcn_fdot2(__builtin_bit_cast(fp2_t, pk.y), vs, tmp[1], false);
    S[2] = __builtin_amdgcn_fdot2(__builtin_bit_cast(fp2_t, pk.z), vs, tmp[2], false); S[3] = __builtin_amdgcn_fdot2(__builtin_bit_cast(fp2_t, pk.w), vs, tmp[3], false);
    float y = 0.f;
#pragma unroll
    for (int i = 0; i < 4; ++i) y = fmaf(S[i], r[i], y);
    return red16(y);
}
typedef __attribute__((address_space(1))) const half_t g_half;
typedef __attribute__((address_space(1))) const h4 g_h4;
typedef __attribute__((address_space(1))) const h8 g_h8;
typedef __attribute__((address_space(1))) float g_float;
DEVI void rwkv_prompt(const Params& p, int l, int b, int h, int rg, int lane) {
    const int vrow = rg * 4 + (lane >> 4), kq = lane & 15;
    const g_half* RWp = (const g_half*)((const half_t*)((const unsigned char*)p.out + OOFF_RW) + (size_t)(b * LP) * 1536 + (h * 64 + kq * 4) * 4);
    const g_half* PRr = (const g_half*)((const half_t*)(p.ws + OFF_RL) + (size_t)(b * LP) * 384 + h * 64 + kq * 4);
    const g_half* PRv = (const g_half*)((const half_t*)(p.ws + OFF_PROJ) + (size_t)(b * LP) * DIN + 384 + 768 + h * 64 + vrow);
    g_float* yout = (g_float*)((float*)(p.ws + OFF_YR) + (size_t)(b * LP) * 384 + h * 64 + vrow);
    const float* mu = p.in[I_MU] + l * RPROJ;
    const float muv = mu[768 + h * 64 + vrow], omv = 1.f - muv;
    float S[4] = {0.f, 0.f, 0.f, 0.f}, pm_v = 0.f;
    constexpr int PD = 12;
    h4 om[PD], kk[PD], rr[PD]; h8 kpka[PD]; half_t vv[PD];
#define RW_LD(u, t) do { const g_half* a_ = RWp + (size_t)(t) * 1536; { const h8 q0_ = *(const g_h8*)a_; om[u] = __builtin_shufflevector(q0_, q0_, 0, 1, 2, 3); kk[u] = __builtin_shufflevector(q0_, q0_, 4, 5, 6, 7); kpka[u] = *(const g_h8*)(a_ + 8); } \
        rr[u] = *(const g_h4*)(PRr + (size_t)(t) * 384); vv[u] = PRv[(size_t)(t) * DIN]; } while (0)
#pragma unroll
    for (int u = 0; u < PD; ++u) RW_LD(u, u);
    for (int t = 0; t < LP; t += PD) {
#pragma unroll
        for (int u = 0; u < PD; ++u) {
            float r[4];
#pragma unroll
            for (int i = 0; i < 4; ++i) r[i] = (float)rr[u][i];
            const float v = fmaf((float)vv[u], omv, pm_v); pm_v = (float)vv[u] * muv;
            const float y = rwkv_step(S, om[u], kk[u], kpka[u], r, v);
            yout[(size_t)(t + u) * 384] = y;
            RW_LD(u, t + PD + u);
        }
    }
#undef RW_LD
    *(float4*)(p.out + O_PRWKV + ((size_t)((l * NB + b) * RH + h) * 64 + vrow) * 64 + kq * 4) = make_float4(S[0], S[1], S[2], S[3]);
}
DEVI void rwkv_sample(const Params& p, int l, int s, int h, int rg, int lane) {
    const int vrow = rg * 4 + (lane >> 4), kq = lane & 15; const size_t row = (size_t)(MP + s);
    const half_t* RWp = (const half_t*)((const unsigned char*)p.out + OOFF_RW) + row * 1536 + (h * 64 + kq * 4) * 4;
    const half_t* PR = (const half_t*)(p.ws + OFF_PROJ) + row * DIN + 384;
    const float* mu = p.in[I_MU] + l * RPROJ; const float* sh = p.in[I_SHIFT] + (size_t)(l * NS + s) * RPROJ;
    const size_t so = ((size_t)((l * NS + s) * RH + h) * 64 + vrow) * 64 + kq * 4;
    const float4 s4 = *(const float4*)(p.in[I_RWKV] + so); float S[4] = {s4.x, s4.y, s4.z, s4.w};
    const h4 c_r = *(const h4*)((const half_t*)(p.ws + OFF_RL) + row * 384 + h * 64 + kq * 4); float r[4];
#pragma unroll
    for (int i = 0; i < 4; ++i) r[i] = (float)c_r[i];
    const float xv = (float)PR[768 + h * 64 + vrow]; const float v = xv + (sh[768 + h * 64 + vrow] - xv) * mu[768 + h * 64 + vrow];
    const float y = rwkv_step(S, *(const h4*)RWp, *(const h4*)(RWp + 4), *(const h8*)(RWp + 8), r, v);
    if (kq == 0) ((float*)(p.ws + OFF_YR))[row * 384 + h * 64 + vrow] = y;
    *(float4*)(p.out + O_SRWKV + so) = make_float4(S[0], S[1], S[2], S[3]);
}
DEVI void lru_item(const Params& p, int l, bool samp, int seq, int j, int c) {
    const half_t* PROJ = (const half_t*)(p.ws + OFF_PROJ); const half_t* LA = (const half_t*)(p.ws + OFF_LA); const half_t* GX = (const half_t*)(p.ws + OFF_GX);
    const float* LCS = (const float*)(p.ws + OFF_LCS); bf16_t* MIX = (bf16_t*)(p.ws + OFF_MIX);
    const float* cw = p.in[I_CW] + l * 4 * 256; const float w0 = cw[c], w1 = cw[256 + c], w2 = cw[512 + c], w3 = cw[768 + c], bb = p.in[I_CB][l * 256 + c];
    const float lmv = p.in[I_LAM][l * 256 + c], ls8 = logsig8(lmv), bav = p.in[I_BA][l * 256 + c], bxv = p.in[I_BX][l * 256 + c];
    float hh = 0.f, xm1, xm2, xm3; size_t row0; int ntok;
    if (samp) { row0 = (size_t)(MP + seq); ntok = 1; hh = p.in[I_LRU][(size_t)(l * NS + seq) * 256 + c];
        const float* c0 = p.in[I_CONV] + (size_t)(l * NS + seq) * 3 * 256 + c; xm3 = c0[0]; xm2 = c0[256]; xm1 = c0[512]; }
    else { const int t0 = j * LC; row0 = (size_t)seq * LP + t0; ntok = LC; const half_t* px = PROJ + row0 * DIN + 1792 + c;
        xm1 = t0 >= 1 ? (float)px[-DIN] : 0.f; xm2 = t0 >= 2 ? (float)px[-2 * DIN] : 0.f; xm3 = t0 >= 3 ? (float)px[-3 * DIN] : 0.f;
        const float* cs = LCS + ((size_t)(seq * NC) * 256 + c) * 2;
        for (int i0 = 0; i0 < j; i0 += 8) { float2 e[8];
#pragma unroll
            for (int u = 0; u < 8; ++u) { const int ii = min(i0 + u, j - 1); e[u] = *(const float2*)(cs + (size_t)ii * 512); }
#pragma unroll
            for (int u = 0; u < 8; ++u) { const bool ok = (i0 + u) < j; hh = ok ? fmaf(hh, e[u].x, e[u].y) : hh; } }
    }
    for (int t8 = 0; t8 < ntok; t8 += 8) { half_t xh[8], glh[8], lh[8], gh[8];
#pragma unroll
        for (int u = 0; u < 8; ++u) { const size_t row = row0 + min(t8 + u, ntok - 1); const half_t* pr = PROJ + row * DIN; xh[u] = pr[1792 + c]; glh[u] = pr[2048 + c]; lh[u] = LA[row * 256 + c]; gh[u] = GX[row * 256 + c]; }
#pragma unroll
        for (int u = 0; u < 8; ++u) if (t8 + u < ntok) { const size_t row = row0 + t8 + u;
            const float x0 = (float)xh[u], gl = (float)glh[u], la = sigm((float)lh[u] + bav) * ls8, gx = sigm((float)gh[u] + bxv);
            const float xc = bb + w0 * xm3 + w1 * xm2 + w2 * xm1 + w3 * x0; const float a = __expf(la); const float bm = sqrtf(fmaxf(1.f - __expf(2.f * la), 0.f));
            hh = a * hh + bm * gx * xc; xm3 = xm2; xm2 = xm1; xm1 = x0;
            MIX[row * DM + 768 + c] = f2bf(hh * gelu_t(gl)); } }
    if (samp) p.out[O_SLRU + (size_t)(l * NS + seq) * 256 + c] = hh;
    else if (j == NC - 1) p.out[O_PLRU + (size_t)(l * NB + seq) * 256 + c] = hh;
}
constexpr int N_S5P = NB * 24 * NC, N_S5S = NS * 24, N_LRP = NB * NC * 4, N_LRS = NS * 4, N_RWS = NS * RH * 16;
DEVI void phase_m2(const Params& p, int l, float* lds) { LAUNDER_IDS;
    const int wid = TIDX >> 6, lane = TIDX & 63;
    const int swi = wid == 0 ? 0 : (wid == 2 ? 1 : (wid == 5 ? 2 : -1)), wki = wid == 1 ? 0 : (wid == 3 ? 1 : (wid == 4 ? 2 : (wid == 6 ? 3 : 4)));
    if (swi >= 0) {
        __builtin_amdgcn_s_setprio(3);
        const int xcd = BIDX & 7, slot = BIDX >> 3;
        for (int q = slot * 3 + swi; q < 96; q += (gridDim.x >> 3) * 3) rwkv_prompt(p, l, xcd, q >> 4, q & 15, lane);
        __builtin_amdgcn_s_setprio(0);
    } else {
        float* ldsH = lds + wki * (128 * 17);
        const int nwk = gridDim.x * 5;
        for (int it = BIDX * 5 + wki; it < N_S5P + N_S5S + N_LRP + N_LRS + N_RWS; it += nwk) {
            int k = it;
            if (k < N_S5P) { const int j = k % NC, sg = k / NC; s5_item<1>(p, l, sg % 24, sg / 24, j, ldsH, lane); continue; }
            k -= N_S5P;
            if (k < N_S5S) { s5_item<2>(p, l, k % 24, k / 24, 0, ldsH, lane); continue; }
            k -= N_S5S;
            if (k < N_LRP) { const int cq = k & 3, bj = k >> 2; lru_item(p, l, false, bj / NC, bj % NC, cq * 64 + lane); continue; }
            k -= N_LRP;
            if (k < N_LRS) { lru_item(p, l, true, k >> 2, 0, (k & 3) * 64 + lane); continue; }
            k -= N_LRS;
            { const int rg = k & 15, sh = k >> 4; rwkv_sample(p, l, sh / RH, sh % RH, rg, lane); }
        }
    }
}
DEVI void phase_m3_fin(const Params& p, int l) { LAUNDER_IDS;
    const half_t* PROJ = (const half_t*)(p.ws + OFF_PROJ); const half_t* RW = (const half_t*)((const unsigned char*)p.out + OOFF_RW); const half_t* GG = (const half_t*)(p.ws + OFF_GG);
    const float* YR = (const float*)(p.ws + OFF_YR); bf16_t* MIX = (bf16_t*)(p.ws + OFF_MIX); const float* mu = p.in[I_MU] + l * RPROJ;
    const int wid = TIDX >> 6, lane = TIDX & 63;
    const bf16_t* Zb = (const bf16_t*)((const unsigned char*)p.out + OOFF_Z); const half_t* GLR = (const half_t*)(p.ws + OFF_GLR);
    struct FinIn { float4 y4, mur4, muv4, rk4, lw4, lb4, gb4; h4 prh, pvh, kph, ggh, glh; uint2 zz; float ppr[4], ppv[4]; int row, col; };
    auto fin_load = [&](int it, FinIn& q) {
        const int pair = it * 4 + (lane >> 4), row = pair / RH, h = pair - row * RH, col = h * 64 + (lane & 15) * 4; q.row = row; q.col = col;
        q.y4 = *(const float4*)(YR + (size_t)row * 384 + col);
        q.prh = *(const h4*)((const half_t*)(p.ws + OFF_RL) + (size_t)row * 384 + col); q.pvh = *(const h4*)(PROJ + (size_t)row * DIN + 384 + 768 + col); { const h8 pk = *(const h8*)(RW + (size_t)row * 1536 + col * 4 + 8); q.kph = __builtin_shufflevector(pk, pk, 0, 2, 4, 6); }
        q.ggh = *(const h4*)(GG + (size_t)row * 384 + col); q.glh = *(const h4*)(GLR + (size_t)row * 384 + col); q.zz = *(const uint2*)(Zb + (size_t)row * 384 + col);
        rw_prev4(p, l, PROJ, row, 768 + col, q.ppv);
        q.mur4 = *(const float4*)(mu + col); q.muv4 = *(const float4*)(mu + 768 + col); q.rk4 = *(const float4*)(p.in[I_RK] + l * 384 + col); q.lw4 = *(const float4*)(p.in[I_LNW] + l * 384 + col);
        q.lb4 = *(const float4*)(p.in[I_LNB] + l * 384 + col); q.gb4 = *(const float4*)(p.in[I_GLUB] + l * 384 + col); };
    auto fin_finish = [&](const FinIn& q) {
        const float y[4] = {q.y4.x, q.y4.y, q.y4.z, q.y4.w}, mur[4] = {q.mur4.x, q.mur4.y, q.mur4.z, q.mur4.w}, muv[4] = {q.muv4.x, q.muv4.y, q.muv4.z, q.muv4.w}, rk[4] = {q.rk4.x, q.rk4.y, q.rk4.z, q.rk4.w},
                    lw[4] = {q.lw4.x, q.lw4.y, q.lw4.z, q.lw4.w}, lb[4] = {q.lb4.x, q.lb4.y, q.lb4.z, q.lb4.w}, gb[4] = {q.gb4.x, q.gb4.y, q.gb4.z, q.gb4.w};
        const float zf[4] = {__uint_as_float(q.zz.x << 16), __uint_as_float(q.zz.x & 0xffff0000u), __uint_as_float(q.zz.y << 16), __uint_as_float(q.zz.y & 0xffff0000u)};
        const float mean = red16(y[0] + y[1] + y[2] + y[3]) * (1.f / 64.f);
        float d[4], vs = 0.f, bs = 0.f, v[4];
#pragma unroll
        for (int i = 0; i < 4; ++i) { d[i] = y[i] - mean; vs = fmaf(d[i], d[i], vs); const float r = (float)q.prh[i]; const float xv = (float)q.pvh[i]; v[i] = xv + (q.ppv[i] - xv) * muv[i];
            bs = fmaf(r * (float)q.kph[i], rk[i], bs); }
        const float rstd = rsqrtf(red16(vs) * (1.f / 64.f) + 64e-5f); bs = red16(bs);
        float o[4], og[4];
#pragma unroll
        for (int i = 0; i < 4; ++i) { o[i] = (d[i] * rstd * lw[i] + lb[i] + bs * v[i]) * (float)q.ggh[i]; og[i] = zf[i] * sigm((float)q.glh[i] + gb[i]); }
        uint2 w; w.x = cvt_pk_bf16(o[0], o[1]); w.y = cvt_pk_bf16(o[2], o[3]); *(uint2*)(MIX + (size_t)q.row * DM + 384 + q.col) = w;
        w.x = cvt_pk_bf16(og[0], og[1]); w.y = cvt_pk_bf16(og[2], og[3]); *(uint2*)(MIX + (size_t)q.row * DM + q.col) = w; };
    { const int nit = M * RH / 4, st = gridDim.x * 8;
      for (int it = BIDX * 8 + wid; it < nit; it += 2 * st) {
          const bool has2 = it + st < nit; FinIn qa, qb; fin_load(it, qa); fin_load(has2 ? it + st : it, qb);
          fin_finish(qa); if (has2) fin_finish(qb); } }
}

#define XB_TMO      128
#define XB_XCNT(j)  (256  + 64 * (j))
#define XB_XSUB(j)  (1280 + 64 * (j))
#define XB_XGEN(j)  (2304 + 64 * (j))
#define XB_TOP      3328
#define XB_TOPGEN   3392
#define XCD_BAR_WORDS 3456
#define XB_SPIN_CAP (1u << 18)
#define XLAS __attribute__((address_space(3)))

__device__ __forceinline__ unsigned xb_ld(unsigned* p)              { return __hip_atomic_load(p, __ATOMIC_RELAXED, __HIP_MEMORY_SCOPE_AGENT); }
__device__ __forceinline__ unsigned xb_add(unsigned* p, unsigned v) { return __hip_atomic_fetch_add(p, v, __ATOMIC_RELAXED, __HIP_MEMORY_SCOPE_AGENT); }
__device__ __forceinline__ unsigned xb_xcc_id() { return (unsigned)__builtin_amdgcn_s_getreg((3 << 11) | 20) & 0xFu; }
#define XB_SPIN(cond, bar) do { unsigned _sp = 0; while (cond) { __builtin_amdgcn_s_sleep(1); \
    if ((++_sp & 255u) == 0u) { if (xb_ld(&(bar)[XB_TMO])) break; if (_sp > XB_SPIN_CAP) { atomicAdd(&(bar)[XB_TMO], 1u); break; } } } } while (0)

struct XcdBarrier {
    unsigned* bar; unsigned x;
    volatile XLAS unsigned* st;
};

__device__ __forceinline__ XcdBarrier xcd_barrier_post(unsigned* bar, volatile XLAS unsigned* st) {
    XcdBarrier b; b.bar = bar; b.x = xb_xcc_id(); b.st = st;
    if (threadIdx.x == 0) (void)xb_add(&bar[XB_XCNT(b.x)], 1u);
    return b;
}
__device__ __forceinline__ void xcd_barrier_complete(unsigned* bar, unsigned x, unsigned& nloc, unsigned& nx) {
    const unsigned G = gridDim.x * gridDim.y * gridDim.z;
    unsigned sum, cnt, mine, sp = 0u;
    for (;;) {
        sum = 0u; cnt = 0u; mine = 0u;
#pragma unroll
        for (unsigned j = 0; j < 16; ++j) { const unsigned c = xb_ld(&bar[XB_XCNT(j)]); sum += c; cnt += (c > 0u) ? 1u : 0u; mine = (j == x) ? c : mine; }
        if (sum == G) break;
        __builtin_amdgcn_s_sleep(1);
        if ((++sp & 255u) == 0u) { if (xb_ld(&bar[XB_TMO])) break; if (sp > XB_SPIN_CAP) { atomicAdd(&bar[XB_TMO], 1u); break; } }
    }
    nloc = mine > 0u ? mine : 1u; nx = cnt > 0u ? cnt : 1u;
}

__device__ __forceinline__ void xcd_barrier(const XcdBarrier& b) {
    asm volatile("s_waitcnt vmcnt(0)" ::: "memory");
    __syncthreads();
    if (threadIdx.x == 0) {
        unsigned* bar = b.bar;
        __builtin_amdgcn_s_waitcnt(0);
        unsigned nloc = b.st[0], nx = b.st[1];
        if (nloc == 0u) { xcd_barrier_complete(bar, b.x, nloc, nx); b.st[0] = nloc; b.st[1] = nx; }
        const unsigned old = xb_add(&bar[XB_XSUB(b.x)], 1u);
        const unsigned gen = old / nloc;
        if (old + 1u == (gen + 1u) * nloc) {
            __builtin_amdgcn_fence(__ATOMIC_RELEASE, "agent");
            asm volatile("s_waitcnt vmcnt(0)" ::: "memory");
            const unsigned og = xb_add(&bar[XB_TOP], 1u);
            const unsigned tg = og / nx;
            if (og + 1u == (tg + 1u) * nx) xb_add(&bar[XB_TOPGEN], 1u);
            else XB_SPIN(xb_ld(&bar[XB_TOPGEN]) == tg, bar);
            __builtin_amdgcn_fence(__ATOMIC_ACQUIRE, "agent");
            xb_add(&bar[XB_XGEN(b.x)], 1u);
            asm volatile("s_waitcnt vmcnt(0)" ::: "memory");
        } else {
            XB_SPIN(xb_ld(&bar[XB_XGEN(b.x)]) == gen, bar);
            __builtin_amdgcn_fence(__ATOMIC_ACQUIRE, "agent");
            asm volatile("s_waitcnt vmcnt(0)" ::: "memory");
        }
    }
    __syncthreads();
}

constexpr int PH_PER_LAYER = 15, N_PHASES = 1 + 2 * PH_PER_LAYER;
__global__ void __launch_bounds__(512, 2) mega(Params p_arg, int ph_begin, int ph_end) {
    extern __shared__ __attribute__((aligned(16))) unsigned char shm[];
    PG8_LAS unsigned char* lds = (PG8_LAS unsigned char*)shm; float* ldsf = (float*)shm;
    __shared__ uint4 xb_words;
    if (threadIdx.x == 0) xb_words = make_uint4(0u, 0u, 0u, 0u);
    __syncthreads();
    XcdBarrier xb;
    { const Params* pq0 = (const Params*)__builtin_amdgcn_kernarg_segment_ptr(); xb = xcd_barrier_post((unsigned*)(pq0->ws + OFF_BAR), (volatile XLAS unsigned*)&xb_words); }
    if (ph_begin < 0) cg::this_grid().sync();
    for (int ph = ph_begin; ph < ph_end; ++ph) {
        if (ph > ph_begin) xcd_barrier(xb);
        const Params* pq = (const Params*)__builtin_amdgcn_kernarg_segment_ptr(); asm volatile("" : "+s"(pq)); const Params& p = *pq;
        bf16_t* WGU = (bf16_t*)(p.ws + OFF_WGU); bf16_t* WD = (bf16_t*)(p.ws + OFF_WD); bf16_t* XN = (bf16_t*)(p.ws + OFF_XN); bf16_t* ACT = (bf16_t*)(p.ws + OFF_ACT);
        float* H = (float*)(p.ws + OFF_H);
        if (ph == 0) { conv_ffn(p, 0, 0, ldsf); conv_mix(p, 0, ldsf); norm_phase<0>(p, p.in[I_F1N]); continue; }
        const int l = (ph - 1) / PH_PER_LAYER, s = (ph - 1) % PH_PER_LAYER;
        int ngemm = 0; const bf16_t* gA = nullptr; const bf16_t* gB = nullptr; int gN = 0, gK = 0; EpiAll E; E.mode = 0;
        E.sw.act = ACT; E.rs.H = H; E.rs.scale = 0.5f; E.rs.row_base = 0; E.rs.pm_mul = 1; E.rs.atomic = 0; int gM = M, resid = 0; E.f16.O0 = nullptr; E.f16.O1 = nullptr; E.f16.O2 = nullptr; E.f16.ld0 = 0; E.f16.ld12 = 0; E.f16.ncols = 0; E.f16.segw = 0; E.f16.cs0 = 1;
        switch (s) {
        case 0: case 12: ngemm = 1; gA = XN; gB = WGU; gN = 2 * DFF; gK = DM; E.mode = 0; break;
        case 1: case 13: ngemm = 2; gM = 16384; gA = ACT; gB = WD; gN = DM; gK = DFF; E.mode = 2; resid = 1; E.f16.O0 = (half_t*)(p.ws + OFF_XN); E.f16.ld0 = DM; E.f16.ncols = DM; break;
        case 10: ngemm = 2; gM = 16384; gA = (const bf16_t*)(p.ws + OFF_MIX); gB = (const bf16_t*)(p.ws + OFF_WOUT); gN = DM; gK = DM; E.mode = 2; resid = 1; E.rs.scale = 1.0f; E.f16.O0 = (half_t*)(p.ws + OFF_PROJ); E.f16.ld0 = DM; E.f16.ncols = DM; break;
        case 2: norm_phase<1>(p, p.in[I_MIXN] + l * DM, DFF / 256, (const half_t*)(p.ws + OFF_XN), 0.5f); break;
        case 3: ngemm = 1; gA = XN; gB = (const bf16_t*)(p.ws + OFF_WIN); gN = DIN; gK = DM; E.mode = 2; E.f16.O0 = (half_t*)(p.ws + OFF_PROJ); E.f16.ld0 = DIN; E.f16.ncols = DIN; break;
        case 4: phase_m1a(p, l, ldsf); break;
        case 5: ngemm = 2; gA = (const bf16_t*)(p.ws + OFF_AX); gB = (const bf16_t*)(p.ws + OFF_WLR); gN = 1280; gK = 256; E.mode = 2;
            E.f16.O0 = (half_t*)((unsigned char*)p.out + OOFF_RW); E.f16.O1 = (half_t*)(p.ws + OFF_AA); E.f16.O2 = (half_t*)(p.ws + OFF_GG); E.f16.ld0 = 1536; E.f16.ld12 = 384; E.f16.ncols = 1152; E.f16.segw = 384; E.f16.cs0 = 4; break;
        case 6: phase_m1c(p, l); break;
        case 7: phase_m2(p, l, ldsf); break;
        case 8: ngemm = 1; gA = (const bf16_t*)((const unsigned char*)p.out + OOFF_Z); gB = (const bf16_t*)(p.ws + OFF_WGLU); gN = 512; gK = 384; E.mode = 2;
            E.f16.O0 = (half_t*)(p.ws + OFF_GLR); E.f16.ld0 = 384; E.f16.ncols = 384; break;
        case 9: phase_m3_fin(p, l); break;
        case 11: conv_ffn(p, l, 1, ldsf); norm_phase<1>(p, p.in[I_F2N] + l * DM, DM / 256, (const half_t*)(p.ws + OFF_PROJ), 1.0f); break;
        case 14: if (l == 1) norm_phase<2>(p, p.in[I_FINN], DFF / 256, (const half_t*)(p.ws + OFF_XN), 0.5f); else { conv_ffn(p, l + 1, 0, ldsf); conv_mix(p, l + 1, ldsf); norm_phase<1>(p, p.in[I_F1N] + (l + 1) * DM, DFF / 256, (const half_t*)(p.ws + OFF_XN), 0.5f); } break;
        }
        int gld = gK; size_t ga_pm = (size_t)256 * gK * 2, gb_pm = 0;
        for (int gi = 0; gi < ngemm; ++gi) {
            if (gi == 1 && !resid) {
                gA = (const bf16_t*)(p.ws + OFF_XC); gB = (const bf16_t*)(p.ws + OFF_WLRU); gN = 512; gK = 256; gld = 256; ga_pm = (size_t)256 * 256 * 2;
                E.f16.O0 = (half_t*)(p.ws + OFF_LA); E.f16.O1 = (half_t*)(p.ws + OFF_GX); E.f16.O2 = E.f16.O1; E.f16.ld0 = 256; E.f16.ld12 = 256; E.f16.ncols = 512; E.f16.segw = 256; E.f16.cs0 = 1; }
            if (gi == 1 && resid) { E.mode = 1;
                gA += (size_t)16384 * gK; gM = 256 * (gK / 256); ga_pm = 512; gb_pm = 512; gK = 256;
                E.rs.H = (float*)(p.ws + OFF_PART); E.rs.row_base = 0; E.rs.pm_mul = 1; E.rs.atomic = 1; }
            run_gemm(lds, gA, gB, gM, gN, gK, gld, ga_pm, gb_pm, E.mode != 1 ? 1 : 0, E);
        }
    }
}

extern "C" void kernel_launch(void* const* d_in, const int* in_sizes, int n_in, void* d_out, int out_size, void* d_ws, size_t ws_size, hipStream_t stream) {
    constexpr size_t kDynLds = pg8::STAGE_BYTES;
    static int grid_blocks = 0;
    if (!grid_blocks) {
        hipFuncSetAttribute((const void*)mega, hipFuncAttributeMaxDynamicSharedMemorySize, (int)kDynLds);
        int dev = 0, cus = 0, per_cu = 0; hipGetDevice(&dev); hipDeviceGetAttribute(&cus, hipDeviceAttributeMultiprocessorCount, dev);
        hipOccupancyMaxActiveBlocksPerMultiprocessor(&per_cu, mega, 512, kDynLds);
        if (per_cu < 1) per_cu = 1;
        grid_blocks = cus;
        if (grid_blocks % 8) grid_blocks -= grid_blocks % 8;
    }
    Params p{};
    for (int i = 0; i < N_IN; ++i) p.in[i] = (const float*)d_in[i];
    p.out = (float*)d_out; p.ws = (unsigned char*)d_ws;
#ifdef MULTI_LAUNCH
    for (int ph = 0; ph < N_PHASES; ++ph) hipLaunchKernelGGL(mega, dim3(grid_blocks), dim3(512), kDynLds, stream, p, ph, ph + 1);
#else
    hipMemsetAsync((unsigned char*)d_ws + OFF_BAR, 0, BAR_BYTES, stream);
    int b = 0, e = N_PHASES; void* args[] = {&p, &b, &e};
    hipError_t err = hipLaunchCooperativeKernel((void*)mega, dim3(grid_blocks), dim3(512), args, kDynLds, stream);
    if (err != hipSuccess) fprintf(stderr, "cooperative launch failed: %s (grid %d)\n", hipGetErrorString(err), grid_blocks);
#endif
}
```
